# Optimizing an MI355X kernel written in HIP

```python
import math
import jax, jax.numpy as jnp
from jax import lax
import numpy as np

D_MODEL = 1024
BATCH = 4
SEQ = 4096
DEPTH = 4
DEC_BATCH = 128
DEC_SEQ = 4
PAST_LEN = 8192
PAGE_SIZE = 128

N_MIXERS = 2
N_ATTN_LAYERS = (DEPTH + 1) // 2
N_CONV_LAYERS = DEPTH // 2
HEAD_DIM = 64
N_HEADS = D_MODEL // HEAD_DIM
N_KV_HEADS = 4
GROUP = N_HEADS // N_KV_HEADS
QKV_DIM = (N_HEADS + 2 * N_KV_HEADS) * HEAD_DIM
WINDOW = 128
BLOCK = 128
ATTN_SCALE = HEAD_DIM ** -0.5
NEG = -1e30
NUM_BUCKETS = 32
MAX_DISTANCE = 128
D_CONV = D_MODEL
CONV_W = 3
N_KEYS = 128
N_EXPERTS = N_KEYS * N_KEYS
PEER_HEADS = 8
D_KEY = 256
D_KEY_HALF = D_KEY // 2
PEER_TOPK = 16
PEER_CHUNK = 256
EPS = 1e-6

kernel_name = "hybrid_swa_shortconv_peer_step"


def rmsnorm(x, g):
    xf = x.astype(jnp.float32)
    y = xf * lax.rsqrt(jnp.mean(xf * xf, axis=-1, keepdims=True) + EPS)
    return (y * g.astype(jnp.float32)).astype(x.dtype)


def t5_bucket(dist):
    n = jnp.maximum(dist, 0)
    max_exact = NUM_BUCKETS // 2
    nf = jnp.maximum(n, 1).astype(jnp.float32)
    large = max_exact + (jnp.log(nf / max_exact) / math.log(MAX_DISTANCE / max_exact)
                         * (NUM_BUCKETS - max_exact)).astype(jnp.int32)
    large = jnp.minimum(large, NUM_BUCKETS - 1)
    return jnp.where(n < max_exact, n, large)


def rel_pos_bias(dist, rel_bias):
    return jnp.transpose(jnp.take(rel_bias, t5_bucket(dist), axis=0), (2, 0, 1))


def qkv_split(xn, w_qkv):
    B, T, _ = xn.shape
    qkv = xn @ w_qkv
    hq = N_HEADS * HEAD_DIM
    hk = N_KV_HEADS * HEAD_DIM
    q = qkv[..., :hq].reshape(B, T, N_HEADS, HEAD_DIM)
    k = qkv[..., hq:hq + hk].reshape(B, T, N_KV_HEADS, HEAD_DIM)
    v = qkv[..., hq + hk:].reshape(B, T, N_KV_HEADS, HEAD_DIM)
    return q, k, v


def window_attention(q, k, v, bias, mask, sinks):
    B, N, Q, _, _ = q.shape
    C = k.shape[2]
    qg = q.reshape(B, N, Q, N_KV_HEADS, GROUP, HEAD_DIM)
    s = jnp.einsum('bnqhgd,bnchd->bnhgqc', qg, k, preferred_element_type=jnp.float32) * ATTN_SCALE
    s = s + bias.reshape(N_KV_HEADS, GROUP, Q, C).astype(jnp.float32)
    s = jnp.where(mask[None, :, None, None], s, NEG)
    sink = sinks.reshape(N_KV_HEADS, GROUP).astype(jnp.float32)[:, :, None, None]
    m = jnp.maximum(jnp.max(s, axis=-1, keepdims=True), sink)
    p = jnp.exp(s - m)
    p = p / (jnp.sum(p, axis=-1, keepdims=True) + jnp.exp(sink - m))
    o = jnp.einsum('bnhgqc,bnchd->bnqhgd', p, v.astype(jnp.float32))
    return o.reshape(B, N, Q, N_HEADS * HEAD_DIM).astype(q.dtype)


def swa_prompt(xn, w_qkv, sinks, w_o, rel_bias):
    B, S, _ = xn.shape
    nb = S // BLOCK
    q, k, v = qkv_split(xn, w_qkv)
    pad = jnp.zeros((B, BLOCK, N_KV_HEADS, HEAD_DIM), k.dtype)
    def band(t):
        prev = jnp.concatenate([pad, t], axis=1)[:, :S].reshape(B, nb, BLOCK, N_KV_HEADS, HEAD_DIM)
        return jnp.concatenate([prev, t.reshape(B, nb, BLOCK, N_KV_HEADS, HEAD_DIM)], axis=2)
    kb, vb = band(k), band(v)
    r = jnp.arange(BLOCK, dtype=jnp.int32)
    c = jnp.arange(2 * BLOCK, dtype=jnp.int32)
    dist = r[:, None] - c[None, :] + BLOCK
    kpos = (jnp.arange(nb, dtype=jnp.int32)[:, None] - 1) * BLOCK + c[None, :]
    mask = ((dist >= 0) & (dist < WINDOW))[None] & (kpos >= 0)[:, None, :]
    o = window_attention(q.reshape(B, nb, BLOCK, N_HEADS, HEAD_DIM), kb, vb,
                         rel_pos_bias(dist, rel_bias), mask, sinks)
    out = o.reshape(B, S, N_HEADS * HEAD_DIM) @ w_o
    rows = min(WINDOW, S)
    return out, k[:, S - rows:], v[:, S - rows:]


def swa_sample(xn, cache_k, cache_v, w_qkv, sinks, w_o, rel_bias):
    B, T, _ = xn.shape
    W = cache_k.shape[1]
    q, k, v = qkv_split(xn, w_qkv)
    kc = jnp.concatenate([cache_k.astype(k.dtype), k], axis=1)
    vc = jnp.concatenate([cache_v.astype(v.dtype), v], axis=1)
    j = jnp.arange(T, dtype=jnp.int32)
    c = jnp.arange(W + T, dtype=jnp.int32)
    dist = j[:, None] + W - c[None, :]
    mask = ((dist >= 0) & (dist < WINDOW))[None]
    o = window_attention(q[:, None], kc[:, None], vc[:, None], rel_pos_bias(dist, rel_bias), mask, sinks)
    out = o.reshape(B, T, N_HEADS * HEAD_DIM) @ w_o
    return out, kc[:, -W:], vc[:, -W:]


def short_conv(xn, buf, w_in, w_conv, w_out):
    T = xn.shape[1]
    bch = xn @ w_in
    b_gate = bch[..., :D_CONV]
    c_gate = bch[..., D_CONV:2 * D_CONV]
    h = bch[..., 2 * D_CONV:]
    u = c_gate * h
    up = jnp.concatenate([buf.astype(u.dtype), u], axis=1)
    y = sum(w_conv[i] * up[:, i:i + T] for i in range(CONV_W))
    return (b_gate * y) @ w_out, up[:, -(CONV_W - 1):]


def peer(xn, w_q, sub_keys, u_tab, v_tab):
    shp = xn.shape
    x2 = xn.reshape(-1, D_MODEL)
    T = x2.shape[0]
    n_chunks = -(-T // PEER_CHUNK)
    xp = jnp.pad(x2, ((0, n_chunks * PEER_CHUNK - T), (0, 0))).reshape(n_chunks, PEER_CHUNK, D_MODEL)

    def one(xc):
        q = (xc @ w_q).reshape(PEER_CHUNK, PEER_HEADS, 2, D_KEY_HALF)
        s = jnp.einsum('thpd,hpkd->thpk', q, sub_keys)
        sv, si = lax.top_k(s, PEER_TOPK)
        cand = (sv[:, :, 0, :, None] + sv[:, :, 1, None, :]).reshape(PEER_CHUNK, PEER_HEADS, -1)
        cidx = (si[:, :, 0, :, None] * N_KEYS + si[:, :, 1, None, :]).reshape(PEER_CHUNK, PEER_HEADS, -1)
        best, pos = lax.top_k(cand, PEER_TOPK)
        idx = jnp.take_along_axis(cidx, pos, axis=-1)
        g = jax.nn.softmax(best.astype(jnp.float32), axis=-1).astype(xc.dtype)
        u = jnp.take(u_tab, idx, axis=0)
        act = jax.nn.gelu(jnp.einsum('td,thkd->thk', xc, u), approximate=False)
        v = jnp.take(v_tab, idx, axis=0)
        return jnp.einsum('thk,thkd->td', g * act, v)

    y = lax.map(one, xp).reshape(-1, D_MODEL)[:T]
    return y.reshape(shp)


def setup_inputs(seed: int = 0) -> dict:
    key = jax.random.key(seed)
    ks = jax.random.split(key, 20)
    n = jax.random.normal
    f32 = jnp.float32
    win_rows = min(WINDOW, PAST_LEN)
    return {
        "x_prompt": n(ks[0], (BATCH, SEQ, D_MODEL), f32),
        "x_sample": n(ks[1], (DEC_BATCH, DEC_SEQ, D_MODEL), f32),
        "cache_k": n(ks[2], (N_ATTN_LAYERS, DEC_BATCH, win_rows, N_KV_HEADS, HEAD_DIM), f32),
        "cache_v": n(ks[3], (N_ATTN_LAYERS, DEC_BATCH, win_rows, N_KV_HEADS, HEAD_DIM), f32),
        "state_conv": n(ks[4], (N_CONV_LAYERS, DEC_BATCH, CONV_W - 1, D_CONV), f32),
        "norm_mix_g": 1.0 + 0.02 * n(ks[5], (DEPTH, D_MODEL), f32),
        "norm_ffn_g": 1.0 + 0.02 * n(ks[6], (DEPTH, D_MODEL), f32),
        "norm_final_g": 1.0 + 0.02 * n(ks[7], (D_MODEL,), f32),
        "rel_bias": 0.5 * n(ks[8], (NUM_BUCKETS, N_HEADS), f32),
        "attn_w_qkv": n(ks[9], (N_ATTN_LAYERS, D_MODEL, QKV_DIM), f32) * D_MODEL ** -0.5,
        "attn_sinks": n(ks[10], (N_ATTN_LAYERS, N_HEADS), f32),
        "attn_w_o": n(ks[11], (N_ATTN_LAYERS, N_HEADS * HEAD_DIM, D_MODEL), f32) * (N_HEADS * HEAD_DIM) ** -0.5,
        "conv_w_in": n(ks[12], (N_CONV_LAYERS, D_MODEL, 3 * D_CONV), f32) * D_MODEL ** -0.5,
        "conv_w": n(ks[13], (N_CONV_LAYERS, CONV_W, D_CONV), f32) * CONV_W ** -0.5,
        "conv_w_out": n(ks[14], (N_CONV_LAYERS, D_CONV, D_MODEL), f32) * D_CONV ** -0.5,
        "peer_w_q": n(ks[15], (DEPTH, D_MODEL, PEER_HEADS * D_KEY), f32) * D_MODEL ** -0.5,
        "peer_sub_keys": n(ks[16], (DEPTH, PEER_HEADS, 2, N_KEYS, D_KEY_HALF), f32) * D_KEY_HALF ** -0.5,
        "peer_u": n(ks[17], (DEPTH, N_EXPERTS, D_MODEL), f32) * D_MODEL ** -0.5,
        "peer_v": n(ks[18], (DEPTH, N_EXPERTS, D_MODEL), f32) * (PEER_HEADS * PEER_TOPK) ** -0.5,
    }


def reference(x_prompt, x_sample, cache_k, cache_v, state_conv, norm_mix_g, norm_ffn_g, norm_final_g,
              rel_bias, attn_w_qkv, attn_sinks, attn_w_o, conv_w_in, conv_w, conv_w_out,
              peer_w_q, peer_sub_keys, peer_u, peer_v):
    hp, hs = x_prompt, x_sample
    kp_l, vp_l, cp_l, ks_l, vs_l, cs_l = [], [], [], [], [], []
    for i in range(DEPTH):
        j = i // N_MIXERS
        g = norm_mix_g[i]
        if i % N_MIXERS == 0:
            mp, kp, vp = swa_prompt(rmsnorm(hp, g), attn_w_qkv[j], attn_sinks[j], attn_w_o[j], rel_bias)
            ms, kn, vn = swa_sample(rmsnorm(hs, g), cache_k[j], cache_v[j], attn_w_qkv[j],
                                    attn_sinks[j], attn_w_o[j], rel_bias)
            kp_l.append(kp); vp_l.append(vp); ks_l.append(kn); vs_l.append(vn)
        else:
            zero_buf = jnp.zeros((hp.shape[0], CONV_W - 1, D_CONV), hp.dtype)
            mp, cp = short_conv(rmsnorm(hp, g), zero_buf, conv_w_in[j], conv_w[j], conv_w_out[j])
            ms, cn = short_conv(rmsnorm(hs, g), state_conv[j], conv_w_in[j], conv_w[j], conv_w_out[j])
            cp_l.append(cp); cs_l.append(cn)
        hp = hp + mp
        hs = hs + ms
        gf = norm_ffn_g[i]
        hp = hp + peer(rmsnorm(hp, gf), peer_w_q[i], peer_sub_keys[i], peer_u[i], peer_v[i])
        hs = hs + peer(rmsnorm(hs, gf), peer_w_q[i], peer_sub_keys[i], peer_u[i], peer_v[i])
    y_prompt = rmsnorm(hp, norm_final_g)
    y_sample = rmsnorm(hs, norm_final_g)
    return (y_prompt, y_sample,
            jnp.stack(kp_l), jnp.stack(vp_l), jnp.stack(cp_l),
            jnp.stack(ks_l), jnp.stack(vs_l), jnp.stack(cs_l))
```

```cpp
#include <hip/hip_runtime.h>
#include <hip/hip_cooperative_groups.h>
#include <cstdio>
namespace cg = cooperative_groups;

typedef unsigned short bf16_t;
typedef short bf16x8 __attribute__((ext_vector_type(8)));
typedef float f32x4 __attribute__((ext_vector_type(4)));
typedef float f32x2 __attribute__((ext_vector_type(2)));
typedef unsigned u32x4 __attribute__((ext_vector_type(4)));
typedef unsigned u32x2 __attribute__((ext_vector_type(2)));

#ifndef PHMASK
#define PHMASK 63
#endif
#ifndef ONE_LAUNCH
#define ONE_LAUNCH 0
#endif

constexpr int TP = 16384, TS = 512, T = TP + TS;
constexpr int NTHREADS = 512;
constexpr int LDS_BYTES = 163840;
constexpr int NPHASES = 21;
constexpr float EPS = 1e-6f;
constexpr long O_YP = 0, O_YS = 16777216, O_KP = 17301504, O_VP = 17563648, O_CP = 17825792, O_KS = 17842176, O_VS = 26230784, O_CS = 34619392;

struct Params {
    const float *x_prompt, *x_sample, *cache_k, *cache_v, *state_conv, *g_mix, *g_ffn, *g_final, *rel_bias, *w_qkv, *sinks, *w_o, *w_in, *conv_w, *w_out, *w_q, *sub_keys, *peer_u, *peer_v;
    float* out;
    float* h; bf16_t* hb; float* ssq; bf16_t *q, *k, *v, *o, *bg, *ub; int* sel_idx; float* sel_g;
    bf16_t *wqkv_t, *wo_t, *win_t, *wout_t, *wq_t, *subk; unsigned char *u8, *v8; float *su, *sv;
    int phase_lo, phase_hi;
};

__device__ const unsigned char kBucket[128] = {0,1,2,3,4,5,6,7,8,9,10,11,12,13,14,15,16,16,16,17,17,18,18,18,19,19,19,20,20,20,20,21,21,21,21,22,22,22,22,22,23,23,23,23,23,23,24,24,24,24,24,24,25,25,25,25,25,25,25,26,26,26,26,26,26,26,26,27,27,27,27,27,27,27,27,27,27,28,28,28,28,28,28,28,28,28,28,29,29,29,29,29,29,29,29,29,29,29,29,30,30,30,30,30,30,30,30,30,30,30,30,30,30,31,31,31,31,31,31,31,31,31,31,31,31,31,31,31};

__device__ __forceinline__ unsigned pk_bf16(float lo, float hi) { unsigned r; asm("v_cvt_pk_bf16_f32 %0, %1, %2" : "=v"(r) : "v"(lo), "v"(hi)); return r; }
__device__ __forceinline__ bf16_t f2bf(float x) { return (bf16_t)(pk_bf16(x, 0.f) & 0xffffu); }
__device__ __forceinline__ float bf2f(unsigned b) { return __uint_as_float(b << 16); }
__device__ __forceinline__ float bflo(unsigned w) { return __uint_as_float(w << 16); }
__device__ __forceinline__ float bfhi(unsigned w) { return __uint_as_float(w & 0xffff0000u); }
__device__ __forceinline__ void wg_barrier() { asm volatile("" ::: "memory"); __builtin_amdgcn_s_barrier(); asm volatile("" ::: "memory"); }
__device__ __forceinline__ void lds_barrier() { asm volatile("s_waitcnt lgkmcnt(0)" ::: "memory"); __builtin_amdgcn_s_barrier(); asm volatile("" ::: "memory"); }
__device__ __forceinline__ void full_barrier() { asm volatile("s_waitcnt vmcnt(0) lgkmcnt(0)" ::: "memory"); __builtin_amdgcn_s_barrier(); asm volatile("" ::: "memory"); }

__device__ __forceinline__ int opaque_tid() { int t = threadIdx.x; asm volatile("" : "+v"(t)); return t; }
template <int CTRL> __device__ __forceinline__ float dpp_f(float v) { return __int_as_float(__builtin_amdgcn_update_dpp(0, __float_as_int(v), CTRL, 0xf, 0xf, false)); }
__device__ __forceinline__ float row16_sum(float v) {
    v += dpp_f<0xB1>(v);
    v += dpp_f<0x4E>(v);
    v += dpp_f<0x141>(v);
    v += dpp_f<0x140>(v);
    return v;
}
__device__ __forceinline__ float wave_sum(float v) {
    v = row16_sum(v);
    v += __shfl_xor(v, 16); v += __shfl_xor(v, 32);
    return v;
}

__device__ __forceinline__ int lds_byte(int r, int c) { int st = (r >> 4) * 2 + (c >> 5), rr = r & 15, cc = c & 31, ob = rr * 64 + cc * 2; return st * 1024 + (ob ^ (((ob >> 9) & 1) << 5)); }
__device__ __forceinline__ void stage_rc(int b, int& R, int& C) { int st = b / 1024, sb = b % 1024, swz = sb ^ (((sb >> 9) & 1) << 5); R = (st >> 1) * 16 + swz / 64; C = (st & 1) * 32 + (swz % 64) / 2; }

__device__ __forceinline__ void stage_half(const bf16_t* G, long row0, int ld, int col0, unsigned char* dst, int tid) {
#pragma unroll
    for (int i = 0; i < 2; ++i) {
        int b = tid * 16 + i * 8192; int R, C; stage_rc(b, R, C);
        __builtin_amdgcn_global_load_lds((const unsigned*)(G + (row0 + R) * ld + col0 + C), (unsigned*)(dst + b), 16, 0, 0);
    }
}

__device__ __forceinline__ f32x4 mfma16(bf16x8 a, bf16x8 b, f32x4 c) { return __builtin_amdgcn_mfma_f32_16x16x32_bf16(a, b, c, 0, 0, 0); }

__device__ __forceinline__ float row_rstd(const float* ssq, long row) {
    const f32x4* p = (const f32x4*)(ssq + row * 16);
    f32x4 a = p[0], b = p[1], c = p[2], d = p[3];
    float s = ((a[0] + a[1]) + (a[2] + a[3])) + ((b[0] + b[1]) + (b[2] + b[3])) + ((c[0] + c[1]) + (c[2] + c[3])) + ((d[0] + d[1]) + (d[2] + d[3]));
    return rsqrtf(s * (1.0f / 1024.0f) + EPS);
}

template <int NBH> struct GemmCfg;
template <> struct GemmCfg<1> { static constexpr int MR = 2, NR = 4; };
template <> struct GemmCfg<2> { static constexpr int MR = 4, NR = 4; };

template <int NBH>
__device__ __forceinline__ void gemm_kloop(const int tid, const bf16_t* A, long arow0, const bf16_t* Bt, long brow0, unsigned char* lds, f32x4 (&acc)[GemmCfg<NBH>::MR][GemmCfg<NBH>::NR]) {
    constexpr int MR = GemmCfg<NBH>::MR, NR = GemmCfg<NBH>::NR;
    constexpr int SS = (1 + NBH) * 16384;
    const int wid = tid >> 6, lane = tid & 63, fr = lane & 15, fq = lane >> 4;
    int arow, bhalf, brow;
    if (NBH == 1) { arow = 32 * (wid >> 1); bhalf = 0; brow = 64 * (wid & 1); }
    else { arow = 64 * (wid >> 2); bhalf = (wid & 3) >> 1; brow = 64 * (wid & 1); }
#pragma unroll
    for (int m = 0; m < MR; ++m)
#pragma unroll
        for (int n = 0; n < NR; ++n) acc[m][n] = (f32x4){0.f, 0.f, 0.f, 0.f};
    auto issue = [&](int kt, int s) {
        unsigned char* base = lds + s * SS;
        stage_half(A, arow0, 1024, kt * 64, base, tid);
#pragma unroll
        for (int hb = 0; hb < NBH; ++hb) stage_half(Bt, brow0 + 128 * hb, 1024, kt * 64, base + 16384 * (1 + hb), tid);
    };
    issue(0, 0);
    for (int t = 0; t < 16; ++t) {
        if (t + 1 < 16) {
            issue(t + 1, (t + 1) & 1);
            if (NBH == 1) asm volatile("s_waitcnt vmcnt(4)" ::: "memory"); else asm volatile("s_waitcnt vmcnt(6)" ::: "memory");
        } else asm volatile("s_waitcnt vmcnt(0)" ::: "memory");
        wg_barrier();
        const unsigned char* Ab = lds + (t & 1) * SS;
        const unsigned char* Bb = Ab + 16384 * (1 + bhalf);
#pragma unroll
        for (int k = 0; k < 2; ++k) {
            bf16x8 a[MR], b[NR];
#pragma unroll
            for (int m = 0; m < MR; ++m) a[m] = *(const bf16x8*)(Ab + lds_byte(arow + 16 * m + fr, 32 * k + 8 * fq));
#pragma unroll
            for (int n = 0; n < NR; ++n) b[n] = *(const bf16x8*)(Bb + lds_byte(brow + 16 * n + fr, 32 * k + 8 * fq));
#pragma unroll
            for (int m = 0; m < MR; ++m)
#pragma unroll
                for (int n = 0; n < NR; ++n) acc[m][n] = mfma16(b[n], a[m], acc[m][n]);
        }
        lds_barrier();
    }
}

__device__ void transpose_tile(const int tid, const float* W, int ldw, int k0, int n0, bf16_t* out, const float* gs, int mode, float* tile) {
    const int tx = tid & 63, ty = tid >> 6;
#pragma unroll
    for (int i = 0; i < 8; ++i) { int k = ty + 8 * i; tile[k * 65 + tx] = W[(long)(k0 + k) * ldw + n0 + tx]; }
    __syncthreads();
    const float g = gs ? gs[k0 + tx] : 1.0f;
#pragma unroll
    for (int i = 0; i < 8; ++i) {
        int n = n0 + ty + 8 * i; int orow = n;
        if (mode == 1 && n >= 1024) { int ch = (n - 1024) & 1023; int isH = (n >= 2048); orow = 1024 + 32 * (ch >> 4) + 16 * isH + (ch & 15); }
        out[(long)orow * 1024 + k0 + tx] = f2bf(tile[tx * 65 + ty + 8 * i] * g);
    }
    __syncthreads();
}

__device__ void prep_phase(const Params& p, unsigned char* lds) {
    const int tid = opaque_tid(), wid = tid >> 6, lane = tid & 63;
    const int G = gridDim.x, B = blockIdx.x;
    float* tile = (float*)lds;
    for (int u = B; u < 5376; u += G) {
        int v = u;
        if (v < 768) { int l = v / 384, r = v % 384, kt = r / 24, nt = r % 24; transpose_tile(tid, p.w_qkv + (long)l * 1024 * 1536, 1536, kt * 64, nt * 64, p.wqkv_t + (long)l * 1536 * 1024, p.g_mix + (2 * l) * 1024, 0, tile); continue; }
        v -= 768;
        if (v < 512) { int l = v / 256, r = v % 256, kt = r / 16, nt = r % 16; transpose_tile(tid, p.w_o + (long)l * 1024 * 1024, 1024, kt * 64, nt * 64, p.wo_t + (long)l * 1024 * 1024, nullptr, 0, tile); continue; }
        v -= 512;
        if (v < 1536) { int l = v / 768, r = v % 768, kt = r / 48, nt = r % 48; transpose_tile(tid, p.w_in + (long)l * 1024 * 3072, 3072, kt * 64, nt * 64, p.win_t + (long)l * 3072 * 1024, p.g_mix + (2 * l + 1) * 1024, 1, tile); continue; }
        v -= 1536;
        if (v < 512) { int l = v / 256, r = v % 256, kt = r / 16, nt = r % 16; transpose_tile(tid, p.w_out + (long)l * 1024 * 1024, 1024, kt * 64, nt * 64, p.wout_t + (long)l * 1024 * 1024, nullptr, 0, tile); continue; }
        v -= 512;
        { int l = v / 512, r = v % 512, kt = r / 32, nt = r % 32; transpose_tile(tid, p.w_q + (long)l * 1024 * 2048, 2048, kt * 64, nt * 64, p.wq_t + (long)l * 2048 * 1024, p.g_ffn + l * 1024, 0, tile); }
    }
    for (int u = B; u < 256; u += G) {
        long e = (long)u * 4096 + tid * 8;
        f32x4 a = *(const f32x4*)(p.sub_keys + e), b = *(const f32x4*)(p.sub_keys + e + 4);
        u32x4 w; w.x = pk_bf16(a[0], a[1]); w.y = pk_bf16(a[2], a[3]); w.z = pk_bf16(b[0], b[1]); w.w = pk_bf16(b[2], b[3]);
        *(u32x4*)(p.subk + e) = w;
    }
    for (int u = B; u < 16384; u += G) {
        int r = u * 8 + wid; int tbl = r >> 16; long rr = r & 65535;
        const float* src = (tbl ? p.peer_v : p.peer_u) + rr * 1024;
        f32x4 x[4]; float am = 0.f;
#pragma unroll
        for (int i = 0; i < 4; ++i) { x[i] = *(const f32x4*)(src + 256 * i + 4 * lane); am = fmaxf(am, fmaxf(fmaxf(fabsf(x[i][0]), fabsf(x[i][1])), fmaxf(fabsf(x[i][2]), fabsf(x[i][3])))); }
#pragma unroll
        for (int o = 32; o >= 1; o >>= 1) am = fmaxf(am, __shfl_xor(am, o));
        float inv = am > 0.f ? 416.0f / am : 0.f; float sc = am > 0.f ? am / 416.0f : 1.0f;
        u32x4 w;
#pragma unroll
        for (int i = 0; i < 4; ++i) { int t0 = __builtin_amdgcn_cvt_pk_fp8_f32(x[i][0] * inv, x[i][1] * inv, 0, false); t0 = __builtin_amdgcn_cvt_pk_fp8_f32(x[i][2] * inv, x[i][3] * inv, t0, true); w[i] = (unsigned)t0; }
        *(u32x4*)((tbl ? p.v8 : p.u8) + rr * 1024 + 16 * lane) = w;
        if (lane == 0) (tbl ? p.sv : p.su)[rr] = sc;
    }
    for (int u = B; u < T / 8; u += G) {
        long t = (long)u * 8 + wid;
        const float* src = t < TP ? p.x_prompt + t * 1024 : p.x_sample + (t - TP) * 1024;
        float ss = 0.f;
#pragma unroll
        for (int i = 0; i < 4; ++i) {
            f32x4 x = *(const f32x4*)(src + 256 * i + 4 * lane);
            *(f32x4*)(p.h + t * 1024 + 256 * i + 4 * lane) = x;
            u32x2 w; w.x = pk_bf16(x[0], x[1]); w.y = pk_bf16(x[2], x[3]);
            *(u32x2*)(p.hb + t * 1024 + 256 * i + 4 * lane) = w;
            ss += (x[0] * x[0] + x[1] * x[1]) + (x[2] * x[2] + x[3] * x[3]);
        }
        ss = wave_sum(ss);
        if (lane < 16) p.ssq[t * 16 + lane] = lane == 0 ? ss : 0.f;
    }
    for (int u = B; u < 7936; u += G) {
        long e = (long)u * 2048 + tid * 4;
        int tens = e >= 8126464; long e2 = tens ? e - 8126464 : e;
        long lb = e2 / (124 * 256); int rem = (int)(e2 % (124 * 256));
        const float* src = (tens ? p.cache_v : p.cache_k) + lb * 32768 + 1024 + rem;
        float* dst = p.out + (tens ? O_VS : O_KS) + lb * 32768 + rem;
        *(f32x4*)dst = *(const f32x4*)src;
    }
}

template <class Epi>
__device__ void gemm_phase(const bf16_t* A, const bf16_t* Bt, int NT, Epi epi, unsigned char* lds) {
    const int nunits = 132 * NT;
    const int tid = opaque_tid(), wid = tid >> 6, lane = tid & 63, fr = lane & 15, fq = lane >> 4, wr = wid >> 1, wc = wid & 1;
    for (int u = blockIdx.x; u < nunits; u += gridDim.x) {
        const int mt = u / NT, nt = u % NT;
        f32x4 acc[2][4];
        gemm_kloop<1>(tid, A, (long)mt * 128, Bt, (long)nt * 128, lds, acc);
        epi(acc, mt * 128 + 32 * wr + fr, nt * 128 + 64 * wc + 4 * fq, nt * 2 + wc, fq);
    }
}

struct EpiQKV {
    const Params& p; int j;
    __device__ __forceinline__ void operator()(f32x4 (&acc)[2][4], int row0, int col0, int part, int fq) const {
#pragma unroll
        for (int mi = 0; mi < 2; ++mi) {
            const long row = row0 + 16 * mi; const float rs = row_rstd(p.ssq, row);
            float* kvout = nullptr;
            bool pr = false;
            if (row < TP) { int s = (int)(row & 4095); if (s >= 3968) { pr = true; kvout = p.out + ((long)(j * 4 + (row >> 12)) * 128 + (s - 3968)) * 256; } }
            else { long ts = row - TP; pr = true; kvout = p.out + ((long)(j * 128 + (ts >> 2)) * 128 + 124 + (ts & 3)) * 256; }
            const long obase_k = row < TP ? O_KP : O_KS, obase_v = row < TP ? O_VP : O_VS;
#pragma unroll
            for (int n = 0; n < 4; ++n) {
                const int col = col0 + 16 * n; f32x4 v = acc[mi][n] * rs;
                u32x2 w; w.x = pk_bf16(v[0], v[1]); w.y = pk_bf16(v[2], v[3]);
                if (col < 1024) *(u32x2*)(p.q + row * 1024 + col) = w;
                else if (col < 1280) { *(u32x2*)(p.k + row * 256 + (col - 1024)) = w; if (pr) *(f32x4*)(kvout + obase_k + (col - 1024)) = v; }
                else { *(u32x2*)(p.v + row * 256 + (col - 1280)) = w; if (pr) *(f32x4*)(kvout + obase_v + (col - 1280)) = v; }
            }
        }
    }
};

struct EpiRes {
    const Params& p;
    __device__ __forceinline__ void operator()(f32x4 (&acc)[2][4], int row0, int col0, int part, int fq) const {
#pragma unroll
        for (int mi = 0; mi < 2; ++mi) {
            const long row = row0 + 16 * mi; float ss = 0.f;
#pragma unroll
            for (int n = 0; n < 4; ++n) {
                const int col = col0 + 16 * n;
                float* hp = p.h + row * 1024 + col;
                f32x4 v = *(const f32x4*)hp + acc[mi][n];
                *(f32x4*)hp = v;
                u32x2 w; w.x = pk_bf16(v[0], v[1]); w.y = pk_bf16(v[2], v[3]);
                *(u32x2*)(p.hb + row * 1024 + col) = w;
                ss += (v[0] * v[0] + v[1] * v[1]) + (v[2] * v[2] + v[3] * v[3]);
            }
            ss += __shfl_xor(ss, 16); ss += __shfl_xor(ss, 32);
            if (fq == 0) p.ssq[row * 16 + part] = ss;
        }
    }
};

struct EpiWin {
    const Params& p; int j;
    __device__ __forceinline__ void operator()(f32x4 (&acc)[2][4], int row0, int col0, int part, int fq) const {
#pragma unroll
        for (int mi = 0; mi < 2; ++mi) {
            const long row = row0 + 16 * mi; const float rs = row_rstd(p.ssq, row);
            if (col0 < 1024) {
#pragma unroll
                for (int n = 0; n < 4; ++n) { f32x4 v = acc[mi][n] * rs; u32x2 w; w.x = pk_bf16(v[0], v[1]); w.y = pk_bf16(v[2], v[3]); *(u32x2*)(p.bg + row * 1024 + col0 + 16 * n) = w; }
            } else {
                float* cout = nullptr;
                if (row < TP) { int s = (int)(row & 4095); if (s >= 4094) cout = p.out + O_CP + ((long)(j * 4 + (row >> 12)) * 2 + (s - 4094)) * 1024; }
                else { long ts = row - TP; if ((ts & 3) >= 2) cout = p.out + O_CS + ((long)(j * 128 + (ts >> 2)) * 2 + ((ts & 3) - 2)) * 1024; }
#pragma unroll
                for (int n = 0; n < 4; n += 2) {
                    const int cc = col0 - 1024 + 16 * n;
                    const int ch = 16 * (cc >> 5) + (cc & 15);
                    f32x4 u = (acc[mi][n] * rs) * (acc[mi][n + 1] * rs);
                    u32x2 w; w.x = pk_bf16(u[0], u[1]); w.y = pk_bf16(u[2], u[3]);
                    *(u32x2*)(p.ub + row * 1024 + ch) = w;
                    if (cout) *(f32x4*)(cout + ch) = u;
                }
            }
        }
    }
};

__device__ __forceinline__ void attn_core(const unsigned char* Ks, const unsigned char* Vt, int vstride, int kb0, bf16x8 q0, bf16x8 q1,
                                          const float* btab_h, int dbase, int cmin, int cmax, float sink, int fr, int fq, f32x4 (&o)[4]) {
    f32x4 s[10];
#pragma unroll
    for (int kb = 0; kb < 10; ++kb) {
        const unsigned char* kr = Ks + (16 * (kb0 + kb) + fr) * 144 + 16 * fq;
        bf16x8 a0 = *(const bf16x8*)kr, a1 = *(const bf16x8*)(kr + 64);
        f32x4 z = (f32x4){0.f, 0.f, 0.f, 0.f};
        z = mfma16(a0, q0, z); z = mfma16(a1, q1, z);
        s[kb] = z;
    }
    float m = sink;
#pragma unroll
    for (int kb = 0; kb < 10; ++kb)
#pragma unroll
        for (int jj = 0; jj < 4; ++jj) {
            const int c = 16 * (kb0 + kb) + 4 * fq + jj; const int dist = dbase - c;
            const bool valid = dist >= 0 && dist < 128 && c >= cmin && c < cmax;
            const float bias = btab_h[dist & 127];
            const float sv = valid ? s[kb][jj] * 0.125f + bias : -1e30f;
            s[kb][jj] = sv; m = fmaxf(m, sv);
        }
    m = fmaxf(m, __shfl_xor(m, 16)); m = fmaxf(m, __shfl_xor(m, 32));
    float l = 0.f;
#pragma unroll
    for (int kb = 0; kb < 10; ++kb)
#pragma unroll
        for (int jj = 0; jj < 4; ++jj) { const float sv = s[kb][jj]; const float pe = sv > -1e29f ? __expf(sv - m) : 0.f; s[kb][jj] = pe; l += pe; }
    l += __shfl_xor(l, 16); l += __shfl_xor(l, 32);
    l += __expf(sink - m);
    const float inv = 1.0f / l;
    bf16x8 pb[5];
#pragma unroll
    for (int kk = 0; kk < 5; ++kk) {
        u32x4 w; w.x = pk_bf16(s[2 * kk][0], s[2 * kk][1]); w.y = pk_bf16(s[2 * kk][2], s[2 * kk][3]); w.z = pk_bf16(s[2 * kk + 1][0], s[2 * kk + 1][1]); w.w = pk_bf16(s[2 * kk + 1][2], s[2 * kk + 1][3]);
        pb[kk] = __builtin_bit_cast(bf16x8, w);
    }
#pragma unroll
    for (int db = 0; db < 4; ++db) {
        f32x4 z = (f32x4){0.f, 0.f, 0.f, 0.f};
#pragma unroll
        for (int kk = 0; kk < 5; ++kk) {
            const unsigned char* vr = Vt + (16 * db + fr) * vstride + (16 * (kb0 + 2 * kk) + 4 * fq) * 2;
            u32x2 lo = *(const u32x2*)vr, hi = *(const u32x2*)(vr + 32);
            u32x4 w; w.x = lo.x; w.y = lo.y; w.z = hi.x; w.w = hi.y;
            z = mfma16(__builtin_bit_cast(bf16x8, w), pb[kk], z);
        }
        o[db] = z * inv;
    }
}

__device__ void attn_phase(const Params& p, int j, unsigned char* lds) {
    const int tid = opaque_tid(), wid = tid >> 6, lane = tid & 63, fr = lane & 15, fq = lane >> 4;
    for (int u = blockIdx.x; u < 768; u += gridDim.x) {
        if (u < 512) {
            const int b = u >> 7, n = (u >> 2) & 31, kvh = u & 3;
            unsigned char* Ks = lds; unsigned char* Vt = lds + 36864; float* btab = (float*)(lds + 70656);
            {
                const int row = tid >> 1, half = tid & 1;
                const long tok = (long)b * 4096 + (long)(n - 1) * 128 + row;
                const bool ok = !(n == 0 && row < 128);
                const u32x4* src = (const u32x4*)(p.k + tok * 256 + kvh * 64 + half * 32);
                u32x4* dst = (u32x4*)(Ks + row * 144 + half * 64);
#pragma unroll
                for (int i = 0; i < 4; ++i) dst[i] = ok ? src[i] : (u32x4){0u, 0u, 0u, 0u};
            }
            {
                const int key = tid & 255, dp = tid >> 8;
                const long tok = (long)b * 4096 + (long)(n - 1) * 128 + key;
                const bool ok = !(n == 0 && key < 128);
                const u32x4* src = (const u32x4*)(p.v + tok * 256 + kvh * 64 + dp * 32);
#pragma unroll
                for (int i = 0; i < 4; ++i) {
                    u32x4 w = ok ? src[i] : (u32x4){0u, 0u, 0u, 0u};
                    bf16_t* dst = (bf16_t*)(Vt + (dp * 32 + 8 * i) * 528 + key * 2);
#pragma unroll
                    for (int e = 0; e < 4; ++e) { dst[(2 * e) * 264] = (bf16_t)(w[e] & 0xffffu); dst[(2 * e + 1) * 264] = (bf16_t)(w[e] >> 16); }
                }
            }
            { const int hl = tid >> 7, dist = tid & 127; btab[hl * 128 + dist] = p.rel_bias[kBucket[dist] * 16 + kvh * 4 + hl]; }
            lds_barrier();
            const int g = wid & 3, qh = wid >> 2, head = kvh * 4 + g;
            const float sink = p.sinks[j * 16 + head];
#pragma unroll 1
            for (int qb = 0; qb < 4; ++qb) {
                const int r0 = 64 * qh + 16 * qb;
                const long tokq = (long)b * 4096 + n * 128 + r0 + fr;
                const bf16_t* qp = p.q + tokq * 1024 + head * 64 + 8 * fq;
                bf16x8 q0 = *(const bf16x8*)qp, q1 = *(const bf16x8*)(qp + 32);
                const int a = r0 >> 4; const int kb0 = a < 6 ? a : 6;
                f32x4 o[4];
                attn_core(Ks, Vt, 528, kb0, q0, q1, btab + g * 128, r0 + fr + 128, n == 0 ? 128 : 0, 256, sink, fr, fq, o);
#pragma unroll
                for (int db = 0; db < 4; ++db) { u32x2 w; w.x = pk_bf16(o[db][0], o[db][1]); w.y = pk_bf16(o[db][2], o[db][3]); *(u32x2*)(p.o + tokq * 1024 + head * 64 + 16 * db + 4 * fq) = w; }
            }
            lds_barrier();
        } else {
            const int su = u - 512, b = su >> 1, kvp = su & 1;
            float* btab = (float*)(lds + 89088);
#pragma unroll
            for (int i = 0; i < 8; ++i) {
                const int e = tid + 512 * i; const int kl = e >> 11, c = (e >> 4) & 127, d = (e & 15) * 4;
                const long off = ((long)(j * 128 + b) * 128 + c) * 256 + (2 * kvp + kl) * 64 + d;
                f32x4 kx = *(const f32x4*)(p.cache_k + off), vx = *(const f32x4*)(p.cache_v + off);
                u32x2 w; w.x = pk_bf16(kx[0], kx[1]); w.y = pk_bf16(kx[2], kx[3]);
                *(u32x2*)(lds + kl * 44544 + c * 144 + d * 2) = w;
                bf16_t* vd = (bf16_t*)(lds + kl * 44544 + 23040 + d * 336 + c * 2);
                vd[0] = f2bf(vx[0]); vd[168] = f2bf(vx[1]); vd[336] = f2bf(vx[2]); vd[504] = f2bf(vx[3]);
            }
            {
                const int kl = tid >> 8, cc = (tid >> 6) & 3, d = tid & 63;
                const long tok = TP + b * 4 + cc;
                *(bf16_t*)(lds + kl * 44544 + (128 + cc) * 144 + d * 2) = p.k[tok * 256 + (2 * kvp + kl) * 64 + d];
                *(bf16_t*)(lds + kl * 44544 + 23040 + d * 336 + (128 + cc) * 2) = p.v[tok * 256 + (2 * kvp + kl) * 64 + d];
            }
            for (int e = tid; e < 2 * 28 * 64; e += NTHREADS) {
                const int kl = e / (28 * 64), r = e % (28 * 64), c = 132 + r / 64, d = r % 64;
                *(bf16_t*)(lds + kl * 44544 + c * 144 + d * 2) = 0;
                *(bf16_t*)(lds + kl * 44544 + 23040 + d * 336 + c * 2) = 0;
            }
            for (int e = tid; e < 1024; e += NTHREADS) { const int hl = e >> 7, dist = e & 127; btab[e] = p.rel_bias[kBucket[dist] * 16 + kvp * 8 + hl]; }
            lds_barrier();
            if (wid < 2) {
                const int kl = wid, kvh = 2 * kvp + kl, g = fr >> 2, jt = fr & 3, head = kvh * 4 + g;
                const long tok = TP + b * 4 + jt;
                const bf16_t* qp = p.q + tok * 1024 + head * 64 + 8 * fq;
                bf16x8 q0 = *(const bf16x8*)qp, q1 = *(const bf16x8*)(qp + 32);
                const float sink = p.sinks[j * 16 + head];
                f32x4 o[4];
                attn_core(lds + kl * 44544, lds + kl * 44544 + 23040, 336, 0, q0, q1, btab + (kl * 4 + g) * 128, jt + 128, 0, 132, sink, fr, fq, o);
#pragma unroll
                for (int db = 0; db < 4; ++db) { u32x2 w; w.x = pk_bf16(o[db][0], o[db][1]); w.y = pk_bf16(o[db][2], o[db][3]); *(u32x2*)(p.o + tok * 1024 + head * 64 + 16 * db + 4 * fq) = w; }
            }
            lds_barrier();
        }
    }
}

__device__ void convz_phase(const Params& p, int j) {
    const float* cw = p.conv_w + j * 3 * 1024;
    const int tid = opaque_tid();
    for (long e = (long)blockIdx.x * NTHREADS + tid; e < (long)T * 128; e += (long)gridDim.x * NTHREADS) {
        const long t = e >> 7; const int c8 = (int)(e & 127) * 8;
        u32x4 bw = *(const u32x4*)(p.bg + t * 1024 + c8);
        u32x4 u0 = *(const u32x4*)(p.ub + t * 1024 + c8);
        float u1[8], u2[8];
        bool h1, h2; const float *s1 = nullptr, *s2 = nullptr;
        if (t < TP) { const int s = (int)(t & 4095); h1 = s >= 1; h2 = s >= 2; }
        else { const long ts = t - TP; const int jt = (int)(ts & 3); const float* st = p.state_conv + ((long)(j * 128 + (ts >> 2)) * 2) * 1024 + c8;
               h1 = jt >= 1; h2 = jt >= 2; if (jt == 0) { s1 = st + 1024; s2 = st; } else if (jt == 1) { s2 = st + 1024; } }
        if (h1) { u32x4 w = *(const u32x4*)(p.ub + (t - 1) * 1024 + c8);
#pragma unroll
            for (int i = 0; i < 4; ++i) { u1[2 * i] = bflo(w[i]); u1[2 * i + 1] = bfhi(w[i]); } }
        else if (s1) { f32x4 a = *(const f32x4*)s1, b = *(const f32x4*)(s1 + 4);
#pragma unroll
            for (int i = 0; i < 4; ++i) { u1[i] = a[i]; u1[4 + i] = b[i]; } }
        else {
#pragma unroll
            for (int i = 0; i < 8; ++i) u1[i] = 0.f; }
        if (h2) { u32x4 w = *(const u32x4*)(p.ub + (t - 2) * 1024 + c8);
#pragma unroll
            for (int i = 0; i < 4; ++i) { u2[2 * i] = bflo(w[i]); u2[2 * i + 1] = bfhi(w[i]); } }
        else if (s2) { f32x4 a = *(const f32x4*)s2, b = *(const f32x4*)(s2 + 4);
#pragma unroll
            for (int i = 0; i < 4; ++i) { u2[i] = a[i]; u2[4 + i] = b[i]; } }
        else {
#pragma unroll
            for (int i = 0; i < 8; ++i) u2[i] = 0.f; }
        float z[8];
#pragma unroll
        for (int i = 0; i < 8; ++i) {
            const float uu = (i & 1) ? bfhi(u0[i >> 1]) : bflo(u0[i >> 1]);
            const float bb = (i & 1) ? bfhi(bw[i >> 1]) : bflo(bw[i >> 1]);
            const float y = cw[c8 + i] * u2[i] + cw[1024 + c8 + i] * u1[i] + cw[2048 + c8 + i] * uu;
            z[i] = bb * y;
        }
        u32x4 w; w.x = pk_bf16(z[0], z[1]); w.y = pk_bf16(z[2], z[3]); w.z = pk_bf16(z[4], z[5]); w.w = pk_bf16(z[6], z[7]);
        *(u32x4*)(p.o + t * 1024 + c8) = w;
    }
}

__device__ __forceinline__ int f2sort(float f) { int b = __float_as_int(f); return b ^ ((b >> 31) & 0x7fffffff); }
__device__ __forceinline__ float sort2f(int s) { return __int_as_float(s ^ ((s >> 31) & 0x7fffffff)); }
#define CE_DESC(a, b) { int _hi = max(a, b), _lo = min(a, b); a = _hi; b = _lo; }
__device__ __forceinline__ void bitonic_merge16(int (&a)[16]) {
#pragma unroll
    for (int jj = 8; jj >= 1; jj >>= 1)
#pragma unroll
        for (int i = 0; i < 16; ++i) { const int l = i ^ jj; if (l > i) CE_DESC(a[i], a[l]); }
}
__device__ __forceinline__ void bitonic_sort16(int (&a)[16]) {
#pragma unroll
    for (int k = 2; k <= 16; k <<= 1)
#pragma unroll
        for (int jj = k >> 1; jj >= 1; jj >>= 1)
#pragma unroll
            for (int i = 0; i < 16; ++i) {
                const int l = i ^ jj;
                if (l > i) { if ((i & k) == 0 || k == 16) { CE_DESC(a[i], a[l]); } else { CE_DESC(a[l], a[i]); } }
            }
}
__device__ const unsigned char kPI[64] = {0,0,0,0,0,0,0,0,0,0,0,0,0,0,0,0,1,1,1,1,1,1,1,1,2,2,2,2,2,3,3,3,3,4,4,4,5,5,6,6,7,7,8,9,10,11,12,13,14,15,0,0,0,0,0,0,0,0,0,0,0,0,0,0};
__device__ const unsigned char kPJ[64] = {0,1,2,3,4,5,6,7,8,9,10,11,12,13,14,15,0,1,2,3,4,5,6,7,0,1,2,3,4,0,1,2,3,0,1,2,0,1,0,1,0,1,0,0,0,0,0,0,0,0,0,0,0,0,0,0,0,0,0,0,0,0,0,0};
constexpr unsigned char cPI[64] = {0,0,0,0,0,0,0,0,0,0,0,0,0,0,0,0,1,1,1,1,1,1,1,1,2,2,2,2,2,3,3,3,3,4,4,4,5,5,6,6,7,7,8,9,10,11,12,13,14,15,0,0,0,0,0,0,0,0,0,0,0,0,0,0};
constexpr unsigned char cPJ[64] = {0,1,2,3,4,5,6,7,8,9,10,11,12,13,14,15,0,1,2,3,4,5,6,7,0,1,2,3,4,0,1,2,3,0,1,2,0,1,0,1,0,1,0,0,0,0,0,0,0,0,0,0,0,0,0,0,0,0,0,0,0,0,0,0};

__device__ void peerq_phase(const Params& p, int layer, unsigned char* lds) {
    const int tid = opaque_tid(), wid = tid >> 6, lane = tid & 63, fr = lane & 15, fq = lane >> 4;
    const bf16_t* Bt = p.wq_t + (long)layer * 2048 * 1024;
    for (int u = blockIdx.x; u < 132 * 8; u += gridDim.x) {
        const int mt = u >> 3, head = u & 7;
        {
            const bf16_t* sk = p.subk + ((long)(layer * 8 + head) * 2) * 128 * 128;
#pragma unroll
            for (int pp = 0; pp < 2; ++pp)
#pragma unroll
                for (int kh = 0; kh < 2; ++kh) stage_half(sk + (long)pp * 128 * 128, 0, 128, kh * 64, lds + 98304 + (pp * 2 + kh) * 16384, tid);
        }
        f32x4 acc[4][4];
        gemm_kloop<2>(tid, p.hb, (long)mt * 128, Bt, (long)head * 256, lds, acc);
        {
            const int wr = wid >> 2, wc = wid & 3;
#pragma unroll
            for (int m = 0; m < 4; ++m) {
                const int r = 64 * wr + 16 * m + fr; const float rs = row_rstd(p.ssq, (long)mt * 128 + r);
#pragma unroll
                for (int n = 0; n < 4; ++n) { f32x4 v = acc[m][n] * rs; u32x2 w; w.x = pk_bf16(v[0], v[1]); w.y = pk_bf16(v[2], v[3]); *(u32x2*)(lds + wc * 16384 + lds_byte(r, 16 * n + 4 * fq)) = w; }
            }
        }
        full_barrier();
        const int wr2 = wid >> 1, wc2 = wid & 1;
        int L[2][2][16];
#pragma unroll
        for (int pp = 0; pp < 2; ++pp) {
            f32x4 sc[2][4];
#pragma unroll
            for (int mi = 0; mi < 2; ++mi)
#pragma unroll
                for (int n = 0; n < 4; ++n) sc[mi][n] = (f32x4){0.f, 0.f, 0.f, 0.f};
#pragma unroll
            for (int kh = 0; kh < 2; ++kh) {
                const unsigned char* Ab = lds + (pp * 2 + kh) * 16384;
                const unsigned char* Bb = lds + 98304 + (pp * 2 + kh) * 16384;
#pragma unroll
                for (int k = 0; k < 2; ++k) {
                    bf16x8 a[2], b[4];
#pragma unroll
                    for (int mi = 0; mi < 2; ++mi) a[mi] = *(const bf16x8*)(Ab + lds_byte(32 * wr2 + 16 * mi + fr, 32 * k + 8 * fq));
#pragma unroll
                    for (int n = 0; n < 4; ++n) b[n] = *(const bf16x8*)(Bb + lds_byte(64 * wc2 + 16 * n + fr, 32 * k + 8 * fq));
#pragma unroll
                    for (int mi = 0; mi < 2; ++mi)
#pragma unroll
                        for (int n = 0; n < 4; ++n) sc[mi][n] = mfma16(b[n], a[mi], sc[mi][n]);
                }
            }
#pragma unroll
            for (int mi = 0; mi < 2; ++mi) {
#pragma unroll
                for (int n = 0; n < 4; ++n)
#pragma unroll
                    for (int jj = 0; jj < 4; ++jj) L[mi][pp][4 * n + jj] = (f2sort(sc[mi][n][jj]) & ~127) | (64 * wc2 + 16 * n + 4 * fq + jj);
                bitonic_sort16(L[mi][pp]);
#pragma unroll
                for (int msk = 16; msk <= 32; msk <<= 1) {
                    int bb[16];
#pragma unroll
                    for (int i = 0; i < 16; ++i) bb[i] = __shfl_xor(L[mi][pp][15 - i], msk);
#pragma unroll
                    for (int i = 0; i < 16; ++i) L[mi][pp][i] = max(L[mi][pp][i], bb[i]);
                    bitonic_merge16(L[mi][pp]);
                }
            }
        }
        lds_barrier();
        int* xl = (int*)lds; int* fl = (int*)(lds + 16384);
        int mine[2][16];
        const int rowmine = 32 * wr2 + 16 * wc2 + fr, rowsend = 32 * wr2 + 16 * (1 - wc2) + fr;
        const int wmask = -wc2;
#pragma unroll
        for (int pp = 0; pp < 2; ++pp) {
#pragma unroll
            for (int i = 0; i < 16; ++i) mine[pp][i] = L[0][pp][i] ^ ((L[0][pp][i] ^ L[1][pp][i]) & wmask);
            if (fq == 0) {
#pragma unroll
                for (int i = 0; i < 16; ++i) xl[rowsend * 32 + pp * 16 + i] = L[1][pp][i] ^ ((L[0][pp][i] ^ L[1][pp][i]) & wmask);
            }
        }
        lds_barrier();
#pragma unroll
        for (int pp = 0; pp < 2; ++pp) {
#pragma unroll
            for (int i = 0; i < 16; ++i) mine[pp][i] = max(mine[pp][i], xl[rowmine * 32 + pp * 16 + 15 - i]);
            bitonic_merge16(mine[pp]);
            if (fq == 0) {
#pragma unroll
                for (int i = 0; i < 16; ++i) fl[rowmine * 32 + pp * 16 + i] = mine[pp][i];
            }
        }
        float av[16], bv[16];
#pragma unroll
        for (int i = 0; i < 16; ++i) { av[i] = sort2f(mine[0][i] & ~127); bv[i] = sort2f(mine[1][i] & ~127); }
        int C[16];
#pragma unroll
        for (int g = 0; g < 4; ++g) {
            int tmp[16];
#pragma unroll
            for (int s = 0; s < 16; ++s) {
                const int idx = g * 16 + s;
                if (idx < 50) tmp[s] = (f2sort(av[cPI[idx]] + bv[cPJ[idx]]) & ~255) | (cPI[idx] << 4) | cPJ[idx];
                else tmp[s] = (int)0x80000000;
            }
            bitonic_sort16(tmp);
            if (g == 0) {
#pragma unroll
                for (int s = 0; s < 16; ++s) C[s] = tmp[s];
            } else {
#pragma unroll
                for (int s = 0; s < 16; ++s) C[s] = max(C[s], tmp[15 - s]);
                bitonic_merge16(C);
            }
        }
        asm volatile("s_waitcnt lgkmcnt(0)" ::: "memory");
        float ev[16]; int eidx[16]; float esum = 0.f;
        const float vmax = sort2f(C[0] & ~255);
#pragma unroll
        for (int s = 0; s < 16; ++s) {
            const float val = sort2f(C[s] & ~255);
            ev[s] = __expf(val - vmax); esum += ev[s];
            const int ai = fl[rowmine * 32 + ((C[s] >> 4) & 15)] & 127, bj = fl[rowmine * 32 + 16 + (C[s] & 15)] & 127;
            eidx[s] = ai * 128 + bj;
        }
        const float einv = 1.0f / esum;
        if (fq == 0) {
            const long t = (long)mt * 128 + rowmine;
            int* di = p.sel_idx + t * 128 + head * 16; float* dg = p.sel_g + t * 128 + head * 16;
#pragma unroll
            for (int s4 = 0; s4 < 4; ++s4) {
                *(u32x4*)(di + 4 * s4) = (u32x4){(unsigned)eidx[4 * s4], (unsigned)eidx[4 * s4 + 1], (unsigned)eidx[4 * s4 + 2], (unsigned)eidx[4 * s4 + 3]};
                *(f32x4*)(dg + 4 * s4) = (f32x4){ev[4 * s4] * einv, ev[4 * s4 + 1] * einv, ev[4 * s4 + 2] * einv, ev[4 * s4 + 3] * einv};
            }
        }
        lds_barrier();
    }
}

__device__ void gather_phase(const Params& p, int layer, unsigned char* lds) {
    float* wlds = (float*)lds;
    const int tid = opaque_tid(), wid = tid >> 6, lane = tid & 63, jl = lane & 15, qg = lane >> 4;
    const unsigned char* U8 = p.u8 + (long)layer * 16384 * 1024; const unsigned char* V8 = p.v8 + (long)layer * 16384 * 1024;
    const float* SU = p.su + layer * 16384; const float* SV = p.sv + layer * 16384;
    const float* gf = p.g_ffn + layer * 1024;
    const bool last = layer == 3;
    const float* gn = last ? p.g_final : p.g_mix + (layer + 1) * 1024;
    for (long t = (long)blockIdx.x * 8 + wid; t < T; t += (long)gridDim.x * 8) {
        const float* hrow = p.h + t * 1024;
        float xn[4][4][4];
        float ss = 0.f;
#pragma unroll
        for (int i = 0; i < 4; ++i)
#pragma unroll
            for (int r = 0; r < 4; ++r) {
                f32x4 v = *(const f32x4*)(hrow + 256 * i + 64 * r + 4 * jl);
                f32x4 g = *(const f32x4*)(gf + 256 * i + 64 * r + 4 * jl);
#pragma unroll
                for (int c = 0; c < 4; ++c) { xn[i][r][c] = v[c] * g[c]; ss += v[c] * v[c]; }
            }
        ss = row16_sum(ss);
        const float rstd = rsqrtf(ss * (1.0f / 1024.0f) + EPS);
#pragma unroll
        for (int i = 0; i < 4; ++i)
#pragma unroll
            for (int r = 0; r < 4; ++r)
#pragma unroll
                for (int c = 0; c < 4; ++c) xn[i][r][c] *= rstd;
        const int* si = p.sel_idx + t * 128; const float* sg = p.sel_g + t * 128;
        float* wl = wlds + wid * 128;
#pragma unroll 2
        for (int kk = 0; kk < 32; ++kk) {
            const int e = si[4 * kk + qg]; const float gk = sg[4 * kk + qg];
            const unsigned char* ur = U8 + (long)e * 1024 + jl * 16;
            u32x4 uw[4];
#pragma unroll
            for (int r = 0; r < 4; ++r) uw[r] = *(const u32x4*)(ur + 256 * r);
            const float scu = SU[e], scv = SV[e];
            float dot = 0.f;
#pragma unroll
            for (int r = 0; r < 4; ++r)
#pragma unroll
                for (int i = 0; i < 4; ++i) {
                    f32x2 lo = __builtin_amdgcn_cvt_pk_f32_fp8((int)uw[r][i], false), hi = __builtin_amdgcn_cvt_pk_f32_fp8((int)uw[r][i], true);
                    dot += xn[i][r][0] * lo[0]; dot += xn[i][r][1] * lo[1]; dot += xn[i][r][2] * hi[0]; dot += xn[i][r][3] * hi[1];
                }
            dot = row16_sum(dot);
            const float hv = dot * scu;
            const float act = 0.5f * hv * (1.0f + erff(hv * 0.70710678118654752f));
            if (jl == 0) wl[4 * kk + qg] = gk * act * scv;
        }
        asm volatile("s_waitcnt lgkmcnt(0)" ::: "memory");
        float y[4][4][4];
#pragma unroll
        for (int i = 0; i < 4; ++i)
#pragma unroll
            for (int r = 0; r < 4; ++r)
#pragma unroll
                for (int c = 0; c < 4; ++c) y[i][r][c] = 0.f;
#pragma unroll 2
        for (int kk = 0; kk < 32; ++kk) {
            const int e = si[4 * kk + qg]; const float wgt = wl[4 * kk + qg];
            const unsigned char* vr = V8 + (long)e * 1024 + jl * 16;
            u32x4 vw[4];
#pragma unroll
            for (int r = 0; r < 4; ++r) vw[r] = *(const u32x4*)(vr + 256 * r);
#pragma unroll
            for (int r = 0; r < 4; ++r)
#pragma unroll
                for (int i = 0; i < 4; ++i) {
                    f32x2 lo = __builtin_amdgcn_cvt_pk_f32_fp8((int)vw[r][i], false), hi = __builtin_amdgcn_cvt_pk_f32_fp8((int)vw[r][i], true);
                    y[i][r][0] += wgt * lo[0]; y[i][r][1] += wgt * lo[1]; y[i][r][2] += wgt * hi[0]; y[i][r][3] += wgt * hi[1];
                }
        }
        float ss2 = 0.f;
        f32x4 hn[4];
#pragma unroll
        for (int i = 0; i < 4; ++i) {
            f32x4 yv;
#pragma unroll
            for (int c = 0; c < 4; ++c) {
                float v0 = y[i][0][c], v1 = y[i][1][c], v2 = y[i][2][c], v3 = y[i][3][c];
                v0 += __shfl_xor(v0, 16); v0 += __shfl_xor(v0, 32); v1 += __shfl_xor(v1, 16); v1 += __shfl_xor(v1, 32);
                v2 += __shfl_xor(v2, 16); v2 += __shfl_xor(v2, 32); v3 += __shfl_xor(v3, 16); v3 += __shfl_xor(v3, 32);
                yv[c] = qg == 0 ? v0 : qg == 1 ? v1 : qg == 2 ? v2 : v3;
            }
            const int d = 256 * i + 64 * qg + 4 * jl;
            hn[i] = *(const f32x4*)(hrow + d) + yv;
            ss2 += (hn[i][0] * hn[i][0] + hn[i][1] * hn[i][1]) + (hn[i][2] * hn[i][2] + hn[i][3] * hn[i][3]);
        }
        ss2 = wave_sum(ss2);
        const float rstd2 = rsqrtf(ss2 * (1.0f / 1024.0f) + EPS);
#pragma unroll
        for (int i = 0; i < 4; ++i) {
            const int d = 256 * i + 64 * qg + 4 * jl; const f32x4 v = hn[i];
            if (!last) {
                *(f32x4*)(p.h + t * 1024 + d) = v;
                u32x2 w; w.x = pk_bf16(v[0], v[1]); w.y = pk_bf16(v[2], v[3]);
                *(u32x2*)(p.hb + t * 1024 + d) = w;
            } else {
                f32x4 g = *(const f32x4*)(gn + d);
                float* dst = t < TP ? p.out + O_YP + t * 1024 + d : p.out + O_YS + (t - TP) * 1024 + d;
                *(f32x4*)dst = v * rstd2 * g;
            }
        }
        if (!last && lane < 16) p.ssq[t * 16 + lane] = lane == 0 ? ss2 : 0.f;
    }
}

__global__ void __launch_bounds__(NTHREADS) mega(Params p) {
    __shared__ __attribute__((aligned(16))) unsigned char lds[LDS_BYTES];
    cg::grid_group grid = cg::this_grid();
    for (int ph = p.phase_lo; ph < p.phase_hi; ++ph) {
        if (ph > p.phase_lo) grid.sync();
        if (ph == 0) { if (PHMASK & 1) prep_phase(p, lds); continue; }
        const int layer = (ph - 1) / 5, sub = (ph - 1) % 5, j = layer >> 1;
        const bool isconv = layer & 1;
        if (sub == 0) {
            if (PHMASK & 2) { if (!isconv) gemm_phase(p.hb, p.wqkv_t + (long)j * 1536 * 1024, 12, EpiQKV{p, j}, lds);
            else gemm_phase(p.hb, p.win_t + (long)j * 3072 * 1024, 24, EpiWin{p, j}, lds); }
        } else if (sub == 1) {
            if (!isconv) { if (PHMASK & 4) attn_phase(p, j, lds); } else { if (PHMASK & 8) convz_phase(p, j); }
        } else if (sub == 2) {
            if (PHMASK & 2) gemm_phase(p.o, (isconv ? p.wout_t : p.wo_t) + (long)j * 1024 * 1024, 8, EpiRes{p}, lds);
        } else if (sub == 3) {
            if (PHMASK & 16) peerq_phase(p, layer, lds);
        } else {
            if (PHMASK & 32) gather_phase(p, layer, lds);
        }
    }
}

extern "C" void kernel_launch(void* const* d_in, const int* in_sizes, int n_in, void* d_out, int out_size, void* d_ws, size_t ws_size, hipStream_t stream) {
    Params p{};
    const float* const* in = (const float* const*)d_in;
    p.x_prompt = in[0]; p.x_sample = in[1]; p.cache_k = in[2]; p.cache_v = in[3]; p.state_conv = in[4]; p.g_mix = in[5]; p.g_ffn = in[6]; p.g_final = in[7]; p.rel_bias = in[8];
    p.w_qkv = in[9]; p.sinks = in[10]; p.w_o = in[11]; p.w_in = in[12]; p.conv_w = in[13]; p.w_out = in[14]; p.w_q = in[15]; p.sub_keys = in[16]; p.peer_u = in[17]; p.peer_v = in[18];
    p.out = (float*)d_out;
    unsigned char* w = (unsigned char*)d_ws; size_t off = 0;
    auto take = [&](size_t bytes) { unsigned char* r = w + off; off += (bytes + 255) & ~(size_t)255; return r; };
    p.h = (float*)take((size_t)T * 1024 * 4); p.hb = (bf16_t*)take((size_t)T * 1024 * 2); p.ssq = (float*)take((size_t)T * 16 * 4);
    p.q = (bf16_t*)take((size_t)T * 1024 * 2); p.k = (bf16_t*)take((size_t)T * 256 * 2); p.v = (bf16_t*)take((size_t)T * 256 * 2);
    p.o = (bf16_t*)take((size_t)T * 1024 * 2); p.bg = (bf16_t*)take((size_t)T * 1024 * 2); p.ub = (bf16_t*)take((size_t)T * 1024 * 2);
    p.sel_idx = (int*)take((size_t)T * 128 * 4); p.sel_g = (float*)take((size_t)T * 128 * 4);
    p.wqkv_t = (bf16_t*)take((size_t)2 * 1536 * 1024 * 2); p.wo_t = (bf16_t*)take((size_t)2 * 1024 * 1024 * 2); p.win_t = (bf16_t*)take((size_t)2 * 3072 * 1024 * 2);
    p.wout_t = (bf16_t*)take((size_t)2 * 1024 * 1024 * 2); p.wq_t = (bf16_t*)take((size_t)4 * 2048 * 1024 * 2); p.subk = (bf16_t*)take((size_t)4 * 8 * 2 * 128 * 128 * 2);
    p.u8 = take((size_t)4 * 16384 * 1024); p.v8 = take((size_t)4 * 16384 * 1024); p.su = (float*)take((size_t)4 * 16384 * 4); p.sv = (float*)take((size_t)4 * 16384 * 4);
    static int grid_blocks = 0;
    if (!grid_blocks) {
        int dev = 0, cus = 0, per_cu = 0;
        hipGetDevice(&dev);
        hipDeviceGetAttribute(&cus, hipDeviceAttributeMultiprocessorCount, dev);
        hipOccupancyMaxActiveBlocksPerMultiprocessor(&per_cu, mega, NTHREADS, 0);
        if (per_cu > 1) per_cu = 1;
        grid_blocks = cus * per_cu;
        if (grid_blocks <= 0) grid_blocks = 256;
    }
#if ONE_LAUNCH
    p.phase_lo = 0; p.phase_hi = NPHASES;
    void* args[] = {&p};
    hipError_t e = hipLaunchCooperativeKernel((void*)mega, dim3(grid_blocks), dim3(NTHREADS), args, 0, stream);
    if (e != hipSuccess) fprintf(stderr, "cooperative launch failed: %s (grid %d)\n", hipGetErrorString(e), grid_blocks);
#else
    for (int ph = 0; ph < NPHASES; ++ph) {
        p.phase_lo = ph; p.phase_hi = ph + 1;
        hipLaunchKernelGGL(mega, dim3(grid_blocks), dim3(NTHREADS), 0, stream, p);
    }
#endif
}
```

```cpp
#include <hip/hip_runtime.h>
#include <hip/hip_cooperative_groups.h>
#include <cstdio>
namespace cg = cooperative_groups;

typedef unsigned short bf16_t;
typedef short bf16x8 __attribute__((ext_vector_type(8)));
typedef float f32x4 __attribute__((ext_vector_type(4)));
typedef float f32x2 __attribute__((ext_vector_type(2)));
typedef unsigned u32x4 __attribute__((ext_vector_type(4)));
typedef unsigned u32x2 __attribute__((ext_vector_type(2)));
typedef int i32x8 __attribute__((ext_vector_type(8)));
typedef int i32x2 __attribute__((ext_vector_type(2)));

#ifndef XPROBE
#define XPROBE 0
#endif
#ifndef DUPMASK
#define DUPMASK 0
#endif
#ifndef ONE_LAUNCH
#define ONE_LAUNCH 1
#define PEER_KEY_SCALE 1048576.0f
#define CVT_QKV_UNITS 512
#endif

constexpr int TP = 16384, TS = 512, T = TP + TS;
constexpr int NTHREADS = 512;
constexpr int LDS_BYTES = 163840;
constexpr int NPHASES = 30;
constexpr float EPS = 1e-6f;
constexpr long O_YP = 0, O_YS = 16777216, O_KP = 17301504, O_VP = 17563648, O_CP = 17825792, O_KS = 17842176, O_VS = 26230784, O_CS = 34619392;

constexpr size_t al256(size_t x) { return (x + 255) & ~(size_t)255; }
constexpr size_t WS_H = 0;
constexpr size_t WS_HB = WS_H + al256((size_t)T * 1024 * 4);
constexpr size_t WS_SSQ = WS_HB + al256((size_t)T * 1024 * 2);
constexpr size_t WS_Q = WS_SSQ + al256((size_t)T * 16 * 4);
constexpr size_t WS_K = WS_Q + al256((size_t)T * 1024 * 2);
constexpr size_t WS_V = WS_K + al256((size_t)T * 256 * 2);
constexpr size_t WS_O = WS_V + al256((size_t)T * 256 * 2);
constexpr size_t WS_BG = WS_O + al256((size_t)T * 1024 * 2);
constexpr size_t WS_UB = WS_BG + al256((size_t)T * 1024 * 2);
constexpr size_t WS_SELI = WS_UB + al256((size_t)T * 1024 * 2);
constexpr size_t WS_SELG = WS_SELI + al256((size_t)T * 128 * 4);
constexpr size_t WS_SELSU = WS_SELG + al256((size_t)T * 128 * 4);
constexpr size_t WS_WQKV = WS_SELSU + al256((size_t)T * 128 * 4);
constexpr size_t WS_WO = WS_WQKV + al256((size_t)2 * 1536 * 1024 * 2);
constexpr size_t WS_WIN = WS_WO + al256((size_t)2 * 1024 * 1024 * 2);
constexpr size_t WS_WOUT = WS_WIN + al256((size_t)2 * 3072 * 1024 * 2);
constexpr size_t WS_WQ = WS_WOUT + al256((size_t)2 * 1024 * 1024 * 2);
constexpr size_t WS_SUBK = WS_WQ + al256((size_t)4 * 2048 * 1024 * 2);
constexpr size_t WS_PART = WS_SUBK + al256((size_t)4 * 8 * 2 * 128 * 128 * 2);
constexpr size_t WS_BAR = WS_PART + al256((size_t)T * 8 * 128 * 4);
constexpr size_t WS_DMY = WS_BAR + al256(16384);
constexpr size_t WS_U8 = WS_DMY + al256((size_t)T * 1024 * 4 + (size_t)T * 1024 * 2 + (size_t)T * 16 * 4 + (size_t)T * 128 * 4 + 4096);
constexpr size_t WS_V8 = WS_U8 + al256((size_t)4 * 16384 * 1024);
constexpr size_t WS_SU = WS_V8 + al256((size_t)4 * 16384 * 1024);
constexpr size_t WS_SV = WS_SU + al256((size_t)4 * 16384 * 4);
constexpr size_t WS_END = WS_SV + al256((size_t)4 * 16384 * 4);

struct Params {
    const float *x_prompt, *x_sample, *cache_k, *cache_v, *state_conv, *g_mix, *g_ffn, *g_final, *rel_bias, *w_qkv, *sinks, *w_o, *w_in, *conv_w, *w_out, *w_q, *sub_keys, *peer_u, *peer_v;
    float* out;
    unsigned char* ws;
    int phase_lo, phase_hi;
    __device__ __forceinline__ float* h() const { return (float*)(ws + WS_H); }
    __device__ __forceinline__ bf16_t* hb() const { return (bf16_t*)(ws + WS_HB); }
    __device__ __forceinline__ float* ssq() const { return (float*)(ws + WS_SSQ); }
    __device__ __forceinline__ bf16_t* q() const { return (bf16_t*)(ws + WS_Q); }
    __device__ __forceinline__ bf16_t* k() const { return (bf16_t*)(ws + WS_K); }
    __device__ __forceinline__ bf16_t* v() const { return (bf16_t*)(ws + WS_V); }
    __device__ __forceinline__ bf16_t* o() const { return (bf16_t*)(ws + WS_O); }
    __device__ __forceinline__ bf16_t* bg() const { return (bf16_t*)(ws + WS_BG); }
    __device__ __forceinline__ bf16_t* ub() const { return (bf16_t*)(ws + WS_UB); }
    __device__ __forceinline__ int* sel_idx() const { return (int*)(ws + WS_SELI); }
    __device__ __forceinline__ float* sel_g() const { return (float*)(ws + WS_SELG); }
    __device__ __forceinline__ float* sel_su() const { return (float*)(ws + WS_SELSU); }
    __device__ __forceinline__ bf16_t* wqkv_t() const { return (bf16_t*)(ws + WS_WQKV); }
    __device__ __forceinline__ bf16_t* wo_t() const { return (bf16_t*)(ws + WS_WO); }
    __device__ __forceinline__ bf16_t* win_t() const { return (bf16_t*)(ws + WS_WIN); }
    __device__ __forceinline__ bf16_t* wout_t() const { return (bf16_t*)(ws + WS_WOUT); }
    __device__ __forceinline__ bf16_t* wq_t() const { return (bf16_t*)(ws + WS_WQ); }
    __device__ __forceinline__ bf16_t* subk() const { return (bf16_t*)(ws + WS_SUBK); }
    __device__ __forceinline__ float* part() const { return (float*)(ws + WS_PART); }
    __device__ __forceinline__ unsigned* bar() const { return (unsigned*)(ws + WS_BAR); }
    __device__ __forceinline__ float* dmy() const { return (float*)(ws + WS_DMY); }
    __device__ __forceinline__ unsigned char* u8() const { return ws + WS_U8; }
    __device__ __forceinline__ unsigned char* v8() const { return ws + WS_V8; }
    __device__ __forceinline__ float* su() const { return (float*)(ws + WS_SU); }
    __device__ __forceinline__ float* sv() const { return (float*)(ws + WS_SV); }
};

__device__ const unsigned char kBucket[128] = {0,1,2,3,4,5,6,7,8,9,10,11,12,13,14,15,16,16,16,17,17,18,18,18,19,19,19,20,20,20,20,21,21,21,21,22,22,22,22,22,23,23,23,23,23,23,24,24,24,24,24,24,25,25,25,25,25,25,25,26,26,26,26,26,26,26,26,27,27,27,27,27,27,27,27,27,27,28,28,28,28,28,28,28,28,28,28,29,29,29,29,29,29,29,29,29,29,29,29,30,30,30,30,30,30,30,30,30,30,30,30,30,30,31,31,31,31,31,31,31,31,31,31,31,31,31,31,31};

__device__ __forceinline__ unsigned pk_bf16(float lo, float hi) { unsigned r; asm("v_cvt_pk_bf16_f32 %0, %1, %2" : "=v"(r) : "v"(lo), "v"(hi)); return r; }
__device__ __forceinline__ bf16_t f2bf(float x) { return (bf16_t)(pk_bf16(x, 0.f) & 0xffffu); }
__device__ __forceinline__ float bf2f(unsigned b) { return __uint_as_float(b << 16); }
__device__ __forceinline__ float bflo(unsigned w) { return __uint_as_float(w << 16); }
__device__ __forceinline__ float bfhi(unsigned w) { return __uint_as_float(w & 0xffff0000u); }
__device__ __forceinline__ void wg_barrier() { asm volatile("" ::: "memory"); __builtin_amdgcn_s_barrier(); asm volatile("" ::: "memory"); }
__device__ __forceinline__ void lds_barrier() { asm volatile("s_waitcnt lgkmcnt(0)" ::: "memory"); __builtin_amdgcn_s_barrier(); asm volatile("" ::: "memory"); }
__device__ __forceinline__ void full_barrier() { asm volatile("s_waitcnt vmcnt(0) lgkmcnt(0)" ::: "memory"); __builtin_amdgcn_s_barrier(); asm volatile("" ::: "memory"); }

__device__ __forceinline__ int lane_id() { int l; asm volatile("v_mbcnt_lo_u32_b32 %0, -1, 0\n\tv_mbcnt_hi_u32_b32 %0, -1, %0" : "=v"(l)); return l; }
__device__ __forceinline__ int opaque_tid(int wv) { int t = (wv << 6) | lane_id(); asm volatile("" : "+v"(t)); return t; }
template <int CTRL> __device__ __forceinline__ float dpp_f(float v) { return __int_as_float(__builtin_amdgcn_update_dpp(0, __float_as_int(v), CTRL, 0xf, 0xf, true)); }
__device__ __forceinline__ float row16_sum(float v) {
    v += dpp_f<0xB1>(v);
    v += dpp_f<0x4E>(v);
    v += dpp_f<0x141>(v);
    v += dpp_f<0x140>(v);
    return v;
}
__device__ __forceinline__ float wave_sum(float v) {
    v = row16_sum(v);
    v += __shfl_xor(v, 16); v += __shfl_xor(v, 32);
    return v;
}

__device__ __forceinline__ int lds_byte(int r, int c) { int st = (r >> 4) * 2 + (c >> 5), rr = r & 15, cc = c & 31, ob = rr * 64 + cc * 2; return st * 1024 + (ob ^ (((ob >> 9) & 1) << 5)); }
__device__ __forceinline__ void stage_rc(int b, int& R, int& C) { int st = b / 1024, sb = b % 1024, swz = sb ^ (((sb >> 9) & 1) << 5); R = (st >> 1) * 16 + swz / 64; C = (st & 1) * 32 + (swz % 64) / 2; }

__device__ __forceinline__ int perm32(int rho) { const int n = rho >> 4, i = rho & 15; return 8 * (i >> 2) + 4 * n + (i & 3); }
__device__ __forceinline__ void stage_half(const bf16_t* G, long row0, int ld, int col0, unsigned char* dst, int tid) {
#pragma unroll
    for (int i = 0; i < 2; ++i) {
        int b = tid * 16 + i * 8192; int R, C; stage_rc(b, R, C);
        __builtin_amdgcn_global_load_lds((const unsigned*)(G + (row0 + R) * ld + col0 + C), (unsigned*)(dst + b), 16, 0, 0);
    }
}

__device__ __forceinline__ void stage_offsets(int tid, int ld, unsigned (&voff)[2]) {
#pragma unroll
    for (int i = 0; i < 2; ++i) { int b = tid * 16 + i * 8192; int R, C; stage_rc(b, R, C); voff[i] = (unsigned)(R * ld + C) * 2u; }
}
__device__ __forceinline__ void stage_half_u(const bf16_t* ubase, const unsigned (&voff)[2], unsigned char* dst, int tid) {
#pragma unroll
    for (int i = 0; i < 2; ++i)
        __builtin_amdgcn_global_load_lds((const unsigned*)((const unsigned char*)ubase + voff[i]), (unsigned*)(dst + tid * 16 + i * 8192), 16, 0, 0);
}

__device__ __forceinline__ f32x4 mfma16(bf16x8 a, bf16x8 b, f32x4 c) { return __builtin_amdgcn_mfma_f32_16x16x32_bf16(a, b, c, 0, 0, 0); }

__device__ __forceinline__ float row_rstd(const float* ssq, long row) {
    const f32x4* p = (const f32x4*)(ssq + (unsigned)(row * 16));
    f32x4 a = p[0], b = p[1], c = p[2], d = p[3];
    float s = ((a[0] + a[1]) + (a[2] + a[3])) + ((b[0] + b[1]) + (b[2] + b[3])) + ((c[0] + c[1]) + (c[2] + c[3])) + ((d[0] + d[1]) + (d[2] + d[3]));
    return rsqrtf(s * (1.0f / 1024.0f) + EPS);
}
__device__ __forceinline__ f32x4 row_ssq_q(const float* ssq, long row, int fq) { return *(const f32x4*)(ssq + (unsigned)(row * 16 + 4 * fq)); }
__device__ __forceinline__ float row_rstd_q(const f32x4 a) {
    float s = (a[0] + a[1]) + (a[2] + a[3]);
    { const auto sw = __builtin_amdgcn_permlane16_swap(__float_as_uint(s), __float_as_uint(s), false, false); const unsigned s0 = sw[0], s1 = sw[1]; s = __uint_as_float(s0) + __uint_as_float(s1); }
    { const auto sw = __builtin_amdgcn_permlane32_swap(__float_as_uint(s), __float_as_uint(s), false, false); const unsigned s0 = sw[0], s1 = sw[1]; s = __uint_as_float(s0) + __uint_as_float(s1); }
    return rsqrtf(s * (1.0f / 1024.0f) + EPS);
}

template <int NBH> struct GemmCfg;
template <> struct GemmCfg<1> { static constexpr int MR = 2, NR = 4; };
template <> struct GemmCfg<2> { static constexpr int MR = 4, NR = 4; };

template <int NBH>
__device__ __forceinline__ void gemm_kloop(const int tid, const bf16_t* A, long arow0, const bf16_t* Bt, long brow0, unsigned char* lds, f32x4 (&acc)[GemmCfg<NBH>::MR][GemmCfg<NBH>::NR]) {
    constexpr int MR = GemmCfg<NBH>::MR, NR = GemmCfg<NBH>::NR;
    constexpr int SS = (1 + NBH) * 16384, NS = NBH == 1 ? 4 : 3, NL = 2 * (1 + NBH);
    const int wid = tid >> 6, lane = tid & 63, fr = lane & 15, fq = lane >> 4;
    int arow, bhalf, brow;
    if (NBH == 1) { arow = 32 * (wid >> 1); bhalf = 0; brow = 64 * (wid & 1); }
    else { arow = 64 * (wid >> 2); bhalf = (wid & 3) >> 1; brow = 64 * (wid & 1); }
#pragma unroll
    for (int m = 0; m < MR; ++m)
#pragma unroll
        for (int n = 0; n < NR; ++n) acc[m][n] = (f32x4){0.f, 0.f, 0.f, 0.f};
    unsigned voff[2]; stage_offsets(tid, 1024, voff);
    auto issue = [&](int kt) {
        unsigned char* base = lds + (kt % NS) * SS;
        stage_half_u(A + (arow0 * 1024 + kt * 64), voff, base, tid);
#pragma unroll
        for (int hb = 0; hb < NBH; ++hb) stage_half_u(Bt + ((brow0 + 128 * hb) * 1024 + kt * 64), voff, base + 16384 * (1 + hb), tid);
    };
#pragma unroll
    for (int kt = 0; kt < NS - 1; ++kt) issue(kt);
#pragma unroll
    for (int t = 0; t < 16; ++t) {
        constexpr int dummy = 0; (void)dummy;
        const int younger = (15 - t) < (NS - 2) ? (15 - t) : (NS - 2);
        if (younger * NL == 12) asm volatile("s_waitcnt vmcnt(12)" ::: "memory");
        else if (younger * NL == 8) asm volatile("s_waitcnt vmcnt(8)" ::: "memory");
        else if (younger * NL == 6) asm volatile("s_waitcnt vmcnt(6)" ::: "memory");
        else if (younger * NL == 4) asm volatile("s_waitcnt vmcnt(4)" ::: "memory");
        else asm volatile("s_waitcnt vmcnt(0)" ::: "memory");
        wg_barrier();
        if (t + NS - 1 < 16) issue(t + NS - 1);
        const unsigned char* Ab = lds + (t % NS) * SS;
        const unsigned char* Bb = Ab + 16384 * (1 + bhalf);
#pragma unroll
        for (int k = 0; k < 2; ++k) {
            bf16x8 a[MR], b[NR];
#pragma unroll
            for (int m = 0; m < MR; ++m) a[m] = *(const bf16x8*)(Ab + lds_byte(arow + 16 * m + fr, 32 * k + 8 * fq));
#pragma unroll
            for (int n = 0; n < NR; ++n) b[n] = *(const bf16x8*)(Bb + lds_byte(brow + 16 * n + fr, 32 * k + 8 * fq));
#pragma unroll
            for (int m = 0; m < MR; ++m)
#pragma unroll
                for (int n = 0; n < NR; ++n) acc[m][n] = mfma16(b[n], a[m], acc[m][n]);
        }
    }
    lds_barrier();
}

struct TileDesc { const float* W; int ldw, k0, n0; bf16_t* out; const float* gs; float hasg; int mode; };
__device__ __forceinline__ TileDesc tile_desc(const Params& p, int u) {
    TileDesc d; int v = u;
    if (v < 768) { int l = v / 384, r = v % 384; d = TileDesc{p.w_qkv + (long)l * 1024 * 1536, 1536, (r / 24) * 64, (r % 24) * 64, p.wqkv_t() + (long)l * 1536 * 1024, p.g_mix + (2 * l) * 1024, 1.f, 0}; return d; }
    v -= 768;
    if (v < 512) { int l = v / 256, r = v % 256; d = TileDesc{p.w_o + (long)l * 1024 * 1024, 1024, (r / 16) * 64, (r % 16) * 64, p.wo_t() + (long)l * 1024 * 1024, p.g_mix, 0.f, 0}; return d; }
    v -= 512;
    if (v < 1536) { int l = v / 768, r = v % 768; d = TileDesc{p.w_in + (long)l * 1024 * 3072, 3072, (r / 48) * 64, (r % 48) * 64, p.win_t() + (long)l * 3072 * 1024, p.g_mix + (2 * l + 1) * 1024, 1.f, 1}; return d; }
    v -= 1536;
    if (v < 512) { int l = v / 256, r = v % 256; d = TileDesc{p.w_out + (long)l * 1024 * 1024, 1024, (r / 16) * 64, (r % 16) * 64, p.wout_t() + (long)l * 1024 * 1024, p.g_mix, 0.f, 0}; return d; }
    v -= 512;
    { int l = v / 512, r = v % 512; d = TileDesc{p.w_q + (long)l * 1024 * 2048, 2048, (r / 32) * 64, (r % 32) * 64, p.wq_t() + (long)l * 2048 * 1024, p.g_ffn + l * 1024, 1.f, 0}; return d; }
}
__device__ __forceinline__ void tile_load(const int tid, const TileDesc& d, f32x4 (&x)[2]) {
#pragma unroll
    for (int i = 0; i < 2; ++i) { const int idx = tid + 512 * i, k = idx >> 4, n4 = idx & 15; x[i] = __builtin_nontemporal_load((const f32x4*)(d.W + (long)(d.k0 + k) * d.ldw + d.n0 + n4 * 4)); }
}
__device__ __forceinline__ void tile_finish(const int tid, const TileDesc& d, const f32x4 (&x)[2], float* tile) {
#pragma unroll
    for (int i = 0; i < 2; ++i) { const int idx = tid + 512 * i, k = idx >> 4, n4 = idx & 15; *(f32x4*)(tile + k * 68 + n4 * 4) = x[i]; }
    __syncthreads();
    const int nl = tid & 63, kq = tid >> 6;
    const f32x4 g0 = *(const f32x4*)(d.gs + d.k0 + 8 * kq), g1 = *(const f32x4*)(d.gs + d.k0 + 8 * kq + 4);
    float v[8];
#pragma unroll
    for (int i = 0; i < 8; ++i) { const float g = (i < 4 ? g0[i] : g1[i - 4]) * d.hasg + (1.0f - d.hasg); v[i] = tile[(8 * kq + i) * 68 + nl] * g; }
    const int n = d.n0 + nl; int orow = n;
    if (d.mode == 1 && n >= 1024) { const int ch = (n - 1024) & 1023; const int isH = (n >= 2048); orow = 1024 + 8 * (ch >> 2) + 4 * isH + (ch & 3); }
    u32x4 w; w.x = pk_bf16(v[0], v[1]); w.y = pk_bf16(v[2], v[3]); w.z = pk_bf16(v[4], v[5]); w.w = pk_bf16(v[6], v[7]);
    *(u32x4*)(d.out + (long)orow * 1024 + d.k0 + 8 * kq) = w;
    __syncthreads();
}

__device__ __forceinline__ void convert_tables(const Params& p, const int wid, const int lane, const int layer, const int first, const int stride, const int lo, const int hi) {
    for (int u = lo + first; u < hi; u += stride) {
        f32x4 x[4][4];
#pragma unroll
        for (int q = 0; q < 4; ++q) {
            const int r = (u * 8 + wid) * 4 + q; const int tbl = r >> 14; const long rr = (long)layer * 16384 + (r & 16383);
            const float* src = (tbl ? p.peer_v : p.peer_u) + rr * 1024;
#pragma unroll
            for (int i = 0; i < 4; ++i) x[q][i] = __builtin_nontemporal_load((const f32x4*)(src + 256 * i + 4 * lane));
        }
#pragma unroll
        for (int q = 0; q < 4; ++q) {
            const int r = (u * 8 + wid) * 4 + q; const int tbl = r >> 14; const long rr = (long)layer * 16384 + (r & 16383);
            float am = 0.f;
#pragma unroll
            for (int i = 0; i < 4; ++i) am = fmaxf(am, fmaxf(fmaxf(fabsf(x[q][i][0]), fabsf(x[q][i][1])), fmaxf(fabsf(x[q][i][2]), fabsf(x[q][i][3]))));
#pragma unroll
            for (int o = 32; o >= 1; o >>= 1) am = fmaxf(am, __shfl_xor(am, o));
            const float inv = am > 0.f ? 416.0f / am : 0.f; const float sc = am > 0.f ? am / 416.0f : 1.0f;
            u32x4 w;
#pragma unroll
            for (int i = 0; i < 4; ++i) { int t0 = __builtin_amdgcn_cvt_pk_fp8_f32(x[q][i][0] * inv, x[q][i][1] * inv, 0, false); t0 = __builtin_amdgcn_cvt_pk_fp8_f32(x[q][i][2] * inv, x[q][i][3] * inv, t0, true); w[i] = (unsigned)t0; }
            *(u32x4*)((tbl ? p.v8() : p.u8()) + (((rr >> 14) * 8 + (lane >> 3)) * 16384 + (rr & 16383)) * 128 + 16 * (lane & 7)) = w;
            if (lane == 0) (tbl ? p.sv() : p.su())[rr] = sc;
        }
    }
}

__device__ __forceinline__ void prep_phase(const int wv, const Params& p, unsigned char* lds) {
    asm volatile("; ==== PHASE prep");
    const int tid = opaque_tid(wv), wid = tid >> 6, lane = tid & 63;
    const int G = gridDim.x; int B = blockIdx.x; asm volatile("" : "+s"(B));
    float* tile = (float*)lds;
    if (B < 5376) {
        TileDesc dc = tile_desc(p, B); f32x4 xc[2]; tile_load(tid, dc, xc);
        for (int u = B; u < 5376; u += G) {
            const int un = u + G < 5376 ? u + G : u;
            const TileDesc dn = tile_desc(p, un); f32x4 xn[2]; tile_load(tid, dn, xn);
            tile_finish(tid, dc, xc, tile);
            dc = dn; xc[0] = xn[0]; xc[1] = xn[1];
        }
    }
    for (int u = B; u < 256; u += G) {
        long e = (long)u * 4096 + tid * 8;
        f32x4 a = __builtin_nontemporal_load((const f32x4*)(p.sub_keys + e)), b = __builtin_nontemporal_load((const f32x4*)(p.sub_keys + e + 4));
        a = a * PEER_KEY_SCALE; b = b * PEER_KEY_SCALE;
        u32x4 w; w.x = pk_bf16(a[0], a[1]); w.y = pk_bf16(a[2], a[3]); w.z = pk_bf16(b[0], b[1]); w.w = pk_bf16(b[2], b[3]);
        *(u32x4*)(p.subk() + e) = w;
    }
    convert_tables(p, wid, lane, 0, B, G, ((G & 7) == 0 && (48 % (G >> 3)) != 0) ? CVT_QKV_UNITS : 0, 1024);
    for (int u = B; u < T / 32; u += G) {
        f32x4 x[4][4];
#pragma unroll
        for (int q = 0; q < 4; ++q) {
            const long t = (long)(u * 8 + wid) * 4 + q;
            const float* src = t < TP ? p.x_prompt + t * 1024 : p.x_sample + (t - TP) * 1024;
#pragma unroll
            for (int i = 0; i < 4; ++i) x[q][i] = __builtin_nontemporal_load((const f32x4*)(src + 256 * i + 4 * lane));
        }
#pragma unroll
        for (int q = 0; q < 4; ++q) {
            const long t = (long)(u * 8 + wid) * 4 + q;
            float ss = 0.f;
#pragma unroll
            for (int i = 0; i < 4; ++i) {
                const f32x4 xv = x[q][i];
                u32x2 w; w.x = pk_bf16(xv[0], xv[1]); w.y = pk_bf16(xv[2], xv[3]);
                *(u32x2*)(p.hb() + t * 1024 + 256 * i + 4 * lane) = w;
                ss += (xv[0] * xv[0] + xv[1] * xv[1]) + (xv[2] * xv[2] + xv[3] * xv[3]);
            }
            ss = wave_sum(ss);
            if (lane < 16) p.ssq()[t * 16 + lane] = lane == 0 ? ss : 0.f;
        }
    }
}

#define LAS __attribute__((address_space(3)))
template <class Epi>
__device__ __forceinline__ void gemm256_units(const int tid, LAS unsigned char* lds, const bf16_t* A, const bf16_t* Bt, const int nN, const int u0, const int G, const int nunits, const Epi& E) {
    constexpr int K = 1024, BK = 64, HALF = 128, HTB = HALF * BK * 2, nt = K / BK;
    const int wid = __builtin_amdgcn_readfirstlane(tid >> 6), lane = tid & 63, wr = wid >> 2, wc = wid & 3, fr = lane & 15, fq = lane >> 4;
    int u = u0;
    if (u >= nunits) return;
    unsigned voff[2], voffB[2];
#pragma unroll
    for (int i = 0; i < 2; ++i) { int R, C; stage_rc(tid * 16 + i * 8192, R, C); const int Rb = Epi::PERM ? ((R & ~31) + perm32(R & 31)) : R;
        voff[i] = (unsigned)(R * K + C) * 2u; voffB[i] = (unsigned)(Rb * K + C) * 2u; }
    const size_t kstep = (size_t)(BK * 2), hstep = (size_t)HALF * K * 2, tstep = 2 * hstep;
    const unsigned ldsw = (unsigned)wid * 1024u;
    const int aoff = lds_byte(wr * 64 + fr, fq * 8), boff = lds_byte(wc * 32 + fr, fq * 8);
#define PG8_SA(b, h) (((b) * 2 + (h)) * HTB)
#define PG8_SB(b, h) ((4 + (b) * 2 + (h)) * HTB)
#define PG8_STAGE_V(bufoff, gbase, vo) do { _Pragma("unroll") for (int _i = 0; _i < 2; ++_i) \
        __builtin_amdgcn_global_load_lds((const unsigned*)((const char*)(gbase) + (vo)[_i]), (LAS unsigned*)(lds + (bufoff) + ldsw + _i * 8192), 16, 0, 0); } while (0)
#define PG8_STAGE(bufoff, gbase) PG8_STAGE_V(bufoff, gbase, voff)
#define PG8_STAGEB(bufoff, gbase) PG8_STAGE_V(bufoff, gbase, voffB)
#define PG8_LDA(dst, b, h) do { _Pragma("unroll") for (int m = 0; m < 4; ++m) _Pragma("unroll") for (int k = 0; k < 2; ++k) dst[m][k] = *(const LAS bf16x8*)(lds + PG8_SA(b, h) + aoff + m * 2048 + k * 1024); } while (0)
#define PG8_LDB(dst, b, h) do { _Pragma("unroll") for (int n = 0; n < 2; ++n) _Pragma("unroll") for (int k = 0; k < 2; ++k) dst[n][k] = *(const LAS bf16x8*)(lds + PG8_SB(b, h) + boff + n * 2048 + k * 1024); } while (0)
#define PG8_MMA(ai, bj, At, Bt_) do { __builtin_amdgcn_s_setprio(1); _Pragma("unroll") for (int m = 0; m < 4; ++m) _Pragma("unroll") for (int n = 0; n < 2; ++n) _Pragma("unroll") for (int k = 0; k < 2; ++k) \
        acc[ai][bj][m][n] = __builtin_amdgcn_mfma_f32_16x16x32_bf16(Bt_[n][k], At[m][k], acc[ai][bj][m][n], 0, 0, 0); __builtin_amdgcn_s_setprio(0); } while (0)
#define PG8_WAIT_V(n) asm volatile("s_waitcnt vmcnt(" #n ")" ::: "memory")
#define PG8_WAIT_L(n) asm volatile("s_waitcnt lgkmcnt(" #n ")" ::: "memory")
#define PG8_BAR __builtin_amdgcn_s_barrier()
#define PG8_SCHED __builtin_amdgcn_sched_barrier(0)
    f32x4 acc[2][2][4][2];
#pragma unroll
    for (int a_ = 0; a_ < 2; ++a_)
#pragma unroll
        for (int b_ = 0; b_ < 2; ++b_)
#pragma unroll
            for (int m = 0; m < 4; ++m)
#pragma unroll
                for (int n = 0; n < 2; ++n) acc[a_][b_][m][n] = (f32x4){0.f, 0.f, 0.f, 0.f};
    bf16x8 At[4][2], B0[2][2], B1[2][2];
    int pm = u / nN, pn = u - pm * nN;
    const char* cA = (const char*)A + (size_t)pm * tstep; const char* cB = (const char*)Bt + (size_t)pn * tstep;
    PG8_STAGEB(PG8_SB(0, 0), cB); PG8_STAGE(PG8_SA(0, 0), cA); PG8_STAGEB(PG8_SB(0, 1), cB + hstep); PG8_STAGE(PG8_SA(0, 1), cA + hstep);
    if (wr == 1) PG8_BAR;
    PG8_WAIT_V(4); PG8_BAR;
    PG8_STAGEB(PG8_SB(1, 0), cB + kstep); PG8_STAGE(PG8_SA(1, 0), cA + kstep); PG8_STAGEB(PG8_SB(1, 1), cB + hstep + kstep);
    PG8_WAIT_V(6); PG8_BAR;
    for (;;) {
        const int un = u + G; const bool has_next = un < nunits;
        const int npm = has_next ? un / nN : pm, npn = has_next ? un - npm * nN : pn;
        const char* nA = (const char*)A + (size_t)npm * tstep; const char* nB = (const char*)Bt + (size_t)npn * tstep;
        for (int t = 0; t < nt; t += 2) {
            const bool last = (t == nt - 2);
            const char* a1 = cA + (size_t)(t + 1) * kstep;
            const char* a2 = last ? nA : cA + (size_t)(t + 2) * kstep; const char* b2 = last ? nB : cB + (size_t)(t + 2) * kstep;
            const char* a3 = a2 + kstep; const char* b3 = b2 + kstep;
            PG8_LDB(B0, 0, 0); PG8_SCHED; PG8_LDA(At, 0, 0); PG8_STAGE(PG8_SA(1, 1), a1 + hstep);
            PG8_WAIT_L(8); PG8_BAR; PG8_WAIT_L(0); PG8_MMA(0, 0, At, B0); PG8_BAR; PG8_SCHED;
            PG8_LDB(B1, 0, 1); PG8_STAGEB(PG8_SB(0, 0), b2);
            PG8_BAR; PG8_WAIT_L(0); PG8_MMA(0, 1, At, B1); PG8_BAR;
            PG8_LDA(At, 0, 1); PG8_STAGE(PG8_SA(0, 0), a2);
            PG8_BAR; PG8_WAIT_L(0); PG8_MMA(1, 0, At, B0); PG8_BAR; PG8_SCHED;
            PG8_STAGEB(PG8_SB(0, 1), b2 + hstep);
            PG8_WAIT_V(6); PG8_BAR; PG8_MMA(1, 1, At, B1); PG8_BAR;
            PG8_LDB(B0, 1, 0); PG8_SCHED; PG8_LDA(At, 1, 0); PG8_STAGE(PG8_SA(0, 1), a2 + hstep);
            PG8_WAIT_L(8); PG8_BAR; PG8_WAIT_L(0); PG8_MMA(0, 0, At, B0); PG8_BAR; PG8_SCHED;
            PG8_LDB(B1, 1, 1); PG8_STAGEB(PG8_SB(1, 0), b3);
            PG8_BAR; PG8_WAIT_L(0); PG8_MMA(0, 1, At, B1); PG8_BAR;
            PG8_LDA(At, 1, 1); PG8_STAGE(PG8_SA(1, 0), a3);
            PG8_BAR; PG8_WAIT_L(0); PG8_MMA(1, 0, At, B0); PG8_BAR; PG8_SCHED;
            PG8_STAGEB(PG8_SB(1, 1), b3 + hstep);
            PG8_WAIT_V(6); PG8_BAR; PG8_MMA(1, 1, At, B1); PG8_BAR;
        }
        if constexpr (!Epi::AFTER_DRAIN) E.tile(acc, pm, pn, wr, wc, fr, fq);
        if (!has_next) break;
#pragma unroll
        for (int a_ = 0; a_ < 2; ++a_)
#pragma unroll
            for (int b_ = 0; b_ < 2; ++b_)
#pragma unroll
                for (int m = 0; m < 4; ++m)
#pragma unroll
                    for (int n = 0; n < 2; ++n) acc[a_][b_][m][n] = (f32x4){0.f, 0.f, 0.f, 0.f};
        u = un; pm = npm; pn = npn; cA = nA; cB = nB;
    }
    PG8_WAIT_V(0);
    if (wr == 0) PG8_BAR;
    PG8_BAR;
    if constexpr (Epi::AFTER_DRAIN) E.tile(acc, pm, pn, wr, wc, fr, fq);
#undef PG8_SA
#undef PG8_SB
#undef PG8_STAGE
#undef PG8_STAGEB
#undef PG8_STAGE_V
#undef PG8_LDA
#undef PG8_LDB
#undef PG8_MMA
#undef PG8_WAIT_V
#undef PG8_WAIT_L
#undef PG8_BAR
#undef PG8_SCHED
}

template <class Epi> struct RowEpi {
    static constexpr bool AFTER_DRAIN = false, PERM = true;
    const Epi& E;
    __device__ __forceinline__ void tile(f32x4 (&acc)[2][2][4][2], int pm, int pn, int wr, int wc, int fr, int fq) const {
#pragma unroll
        for (int ai = 0; ai < 2; ++ai) {
            typename Epi::Ctx ctx[4];
#pragma unroll
            for (int m = 0; m < 4; ++m) {
                const long row = (long)pm * 256 + ai * 128 + wr * 64 + m * 16 + fr;
                E.row_fetch(ctx[m], row, fq);
#pragma unroll
                for (int bj = 0; bj < 2; ++bj) E.preload(ctx[m], bj, row, pn * 256 + bj * 128 + wc * 32 + 8 * fq);
            }
#pragma unroll
            for (int m = 0; m < 4; ++m) E.row_begin(ctx[m], (long)pm * 256 + ai * 128 + wr * 64 + m * 16 + fr, fq);
#pragma unroll
            for (int m = 0; m < 4; ++m) {
                const long row = (long)pm * 256 + ai * 128 + wr * 64 + m * 16 + fr;
#pragma unroll
                for (int bj = 0; bj < 2; ++bj) E.pair8(ctx[m], bj, row, pn * 256 + bj * 128 + wc * 32 + 8 * fq, acc[ai][bj][m][0], acc[ai][bj][m][1]);
                E.row_end(ctx[m], row, pn * 4 + wc, fq);
            }
        }
        asm volatile("s_waitcnt vmcnt(0)" ::: "memory");
    }
};
template <class Epi>
__device__ __forceinline__ void gemm_phase(const int wv, const bf16_t* A, const bf16_t* Bt, int nN, const Epi& E, unsigned char* lds, const int gx, const int gt) {
    asm volatile("; ==== PHASE gemm");
    const int tid = opaque_tid(wv);
    const bool xmap = (gridDim.x & 7) == 0;
    const int U8 = 8 * nN, G8 = (int)gridDim.x >> 3;
    const int bu0 = xmap ? gx * U8 + gt : (int)blockIdx.x, bus = xmap ? G8 : (int)gridDim.x, bub = xmap ? (gx + 1) * U8 : 64 * nN;
    for (int xr = 0; xr < ((XPROBE == 1 && Epi::IDEMPOTENT) ? 2 : 1); ++xr)
    gemm256_units(tid, (LAS unsigned char*)lds, A, Bt, nN, bu0, bus, bub, RowEpi<Epi>{E});
    const int wid = tid >> 6, lane = tid & 63, fr = lane & 15, fq = lane >> 4;
    const int nct = 4 * nN, nsmall = 8 * nct;
    unsigned voff, voffb; { int R, C; stage_rc(tid * 16, R, C); voff = (unsigned)(R * 1024 + C) * 2u; voffb = (unsigned)(((R & ~31) + perm32(R & 31)) * 1024 + C) * 2u; }
    const int remu = U8 % G8, nlight = (xmap && remu) ? (G8 - remu) * 8 : (int)gridDim.x;
    const int sidx = xmap ? (G8 - 1 - gt) * 8 + gx : (int)gridDim.x - 1 - (int)blockIdx.x;
    for (int xr = 0; xr < ((XPROBE == 2 && Epi::IDEMPOTENT) ? 2 : 1); ++xr)
    for (int us = sidx < nlight ? sidx : nsmall; us < nsmall; us += nlight) {
        const int rt = us / nct, ct = us - rt * nct;
        const unsigned char* ag = (const unsigned char*)(A + ((long)TP + 64 * rt) * 1024) + voff;
        const unsigned char* bg = (const unsigned char*)(Bt + (long)(64 * ct) * 1024) + voffb;
        auto issue = [&](int kt) {
            unsigned char* slot = lds + (kt & 7) * 16384;
            __builtin_amdgcn_global_load_lds((const unsigned*)(ag + kt * 128), (unsigned*)(slot + tid * 16), 16, 0, 0);
            __builtin_amdgcn_global_load_lds((const unsigned*)(bg + kt * 128), (unsigned*)(slot + 8192 + tid * 16), 16, 0, 0);
        };
        f32x4 acc[4];
#pragma unroll
        for (int n = 0; n < 4; ++n) acc[n] = (f32x4){0.f, 0.f, 0.f, 0.f};
#pragma unroll
        for (int kt = 0; kt < 7; ++kt) issue(kt);
#pragma unroll
        for (int t = 0; t < 16; ++t) {
            const int younger = (15 - t) < 6 ? (15 - t) : 6;
            if (younger == 6) asm volatile("s_waitcnt vmcnt(12)" ::: "memory");
            else if (younger == 5) asm volatile("s_waitcnt vmcnt(10)" ::: "memory");
            else if (younger == 4) asm volatile("s_waitcnt vmcnt(8)" ::: "memory");
            else if (younger == 3) asm volatile("s_waitcnt vmcnt(6)" ::: "memory");
            else if (younger == 2) asm volatile("s_waitcnt vmcnt(4)" ::: "memory");
            else if (younger == 1) asm volatile("s_waitcnt vmcnt(2)" ::: "memory");
            else asm volatile("s_waitcnt vmcnt(0)" ::: "memory");
            wg_barrier();
            if (t + 7 < 16) issue(t + 7);
            if (wid < 4) {
                const unsigned char* Ab = lds + (t & 7) * 16384; const unsigned char* Bb = Ab + 8192;
#pragma unroll
                for (int k = 0; k < 2; ++k) {
                    const bf16x8 a = *(const bf16x8*)(Ab + lds_byte(16 * wid + fr, 32 * k + 8 * fq));
#pragma unroll
                    for (int n = 0; n < 4; ++n) acc[n] = mfma16(*(const bf16x8*)(Bb + lds_byte(16 * n + fr, 32 * k + 8 * fq)), a, acc[n]);
                }
            }
        }
        lds_barrier();
        if (wid < 4) {
            const long row = (long)TP + 64 * rt + 16 * wid + fr; const int col0 = 64 * ct + 8 * fq;
            typename Epi::Ctx ctx; E.row_fetch(ctx, row, fq);
            E.preload(ctx, 0, row, col0); E.preload(ctx, 1, row, col0 + 32);
            E.row_begin(ctx, row, fq);
            E.pair8(ctx, 0, row, col0, acc[0], acc[1]);
            E.pair8(ctx, 1, row, col0 + 32, acc[2], acc[3]);
            E.row_end(ctx, row, ct, fq);
        }
    }
    if constexpr (Epi::CONVERT) {
        if (xmap && remu != 0 && sidx < nlight) convert_tables(E.p, wid, lane, 2 * E.j, sidx, nlight, 0, CVT_QKV_UNITS);
    }
}

struct EpiQKV {
    static constexpr bool IDEMPOTENT = true, CONVERT = true;
    const Params& p; int j;
    struct Ctx { float rs; int ko, vo; f32x4 part; };
    __device__ __forceinline__ void row_fetch(Ctx& c, long row, int fq) const { c.part = row_ssq_q(p.ssq(), row, fq); }
    __device__ __forceinline__ void preload(Ctx&, int, long, int) const {}
    __device__ __forceinline__ void row_begin(Ctx& c, long row, int fq) const {
        c.rs = row_rstd_q(c.part);
        int ko = -1, vo = -1;
        if (row < TP) { const int s = (int)(row & 4095); if (s >= 3968) { const int r = ((j * 4 + (int)(row >> 12)) * 128 + (s - 3968)) * 256; ko = (int)O_KP + r; vo = (int)O_VP + r; } }
        else { const int ts = (int)(row - TP); const int r = ((j * 128 + (ts >> 2)) * 128 + 124 + (ts & 3)) * 256; ko = (int)O_KS + r; vo = (int)O_VS + r; }
        c.ko = ko; c.vo = vo;
    }
    __device__ __forceinline__ void pair8(const Ctx& c, int, long row, int col, f32x4 a0, f32x4 a1) const {
        const f32x4 v0 = a0 * c.rs, v1 = a1 * c.rs;
        u32x4 w; w.x = pk_bf16(v0[0], v0[1]); w.y = pk_bf16(v0[2], v0[3]); w.z = pk_bf16(v1[0], v1[1]); w.w = pk_bf16(v1[2], v1[3]);
        if (col < 1024) *(u32x4*)(p.q() + row * 1024 + col) = w;
        else if (col < 1280) { *(u32x4*)(p.k() + row * 256 + (col - 1024)) = w; if (c.ko >= 0) { float* o = p.out + (unsigned)(c.ko + (col - 1024)); __builtin_nontemporal_store(v0, (f32x4*)o); __builtin_nontemporal_store(v1, (f32x4*)(o + 4)); } }
        else { *(u32x4*)(p.v() + row * 256 + (col - 1280)) = w; if (c.vo >= 0) { float* o = p.out + (unsigned)(c.vo + (col - 1280)); __builtin_nontemporal_store(v0, (f32x4*)o); __builtin_nontemporal_store(v1, (f32x4*)(o + 4)); } }
    }
    __device__ __forceinline__ void row_end(Ctx&, long, int, int) const {}
};

struct EpiRes {
    static constexpr bool IDEMPOTENT = false, CONVERT = false;
    const bf16_t* hin; bf16_t* hbout; float* ssqout;
    struct Ctx { float ss; u32x4 hw[2]; };
    __device__ __forceinline__ void row_fetch(Ctx&, long, int) const {}
    __device__ __forceinline__ void row_begin(Ctx& c, long, int) const { c.ss = 0.f; }
    __device__ __forceinline__ void preload(Ctx& c, int k, long row, int col) const { c.hw[k] = *(const u32x4*)(hin + row * 1024 + col); }
    __device__ __forceinline__ void pair8(Ctx& c, int k, long row, int col, f32x4 a0, f32x4 a1) const {
        const u32x4 hw = c.hw[k];
        const f32x4 v0 = (f32x4){bflo(hw.x), bfhi(hw.x), bflo(hw.y), bfhi(hw.y)} + a0, v1 = (f32x4){bflo(hw.z), bfhi(hw.z), bflo(hw.w), bfhi(hw.w)} + a1;
        u32x4 w; w.x = pk_bf16(v0[0], v0[1]); w.y = pk_bf16(v0[2], v0[3]); w.z = pk_bf16(v1[0], v1[1]); w.w = pk_bf16(v1[2], v1[3]);
        *(u32x4*)(hbout + row * 1024 + col) = w;
        c.ss += ((v0[0] * v0[0] + v0[1] * v0[1]) + (v0[2] * v0[2] + v0[3] * v0[3])) + ((v1[0] * v1[0] + v1[1] * v1[1]) + (v1[2] * v1[2] + v1[3] * v1[3]));
    }
    __device__ __forceinline__ void row_end(Ctx& c, long row, int part, int fq) const {
        float ss = c.ss; ss += __shfl_xor(ss, 16); ss += __shfl_xor(ss, 32);
        if (fq == 0) ssqout[row * 16 + part] = ss;
    }
};

struct EpiWin {
    static constexpr bool IDEMPOTENT = true, CONVERT = false;
    const Params& p; int j;
    struct Ctx { float rs; int co; f32x4 part; };
    __device__ __forceinline__ void row_fetch(Ctx& c, long row, int fq) const { c.part = row_ssq_q(p.ssq(), row, fq); }
    __device__ __forceinline__ void preload(Ctx&, int, long, int) const {}
    __device__ __forceinline__ void row_begin(Ctx& c, long row, int fq) const {
        c.rs = row_rstd_q(c.part); int co = -1;
        if (row < TP) { const int s = (int)(row & 4095); if (s >= 4094) co = (int)O_CP + ((j * 4 + (int)(row >> 12)) * 2 + (s - 4094)) * 1024; }
        else { const int ts = (int)(row - TP); if ((ts & 3) >= 2) co = (int)O_CS + ((j * 128 + (ts >> 2)) * 2 + ((ts & 3) - 2)) * 1024; }
        c.co = co;
    }
    __device__ __forceinline__ void pair8(Ctx& c, int, long row, int col, f32x4 a0, f32x4 a1) const {
        if (col < 1024) {
            const f32x4 v0 = a0 * c.rs, v1 = a1 * c.rs;
            u32x4 w; w.x = pk_bf16(v0[0], v0[1]); w.y = pk_bf16(v0[2], v0[3]); w.z = pk_bf16(v1[0], v1[1]); w.w = pk_bf16(v1[2], v1[3]);
            *(u32x4*)(p.bg() + row * 1024 + col) = w;
        } else {
            const int ch = (col - 1024) >> 1;
            const f32x4 u = (a0 * c.rs) * (a1 * c.rs);
            u32x2 w; w.x = pk_bf16(u[0], u[1]); w.y = pk_bf16(u[2], u[3]);
            *(u32x2*)(p.ub() + row * 1024 + ch) = w;
            if (c.co >= 0) __builtin_nontemporal_store(u, (f32x4*)(p.out + (unsigned)(c.co + ch)));
        }
    }
    __device__ __forceinline__ void row_end(Ctx&, long, int, int) const {}
};

__device__ __forceinline__ void attn_core(const unsigned char* Ks, const unsigned char* Vt, int vstride, int kb0, bf16x8 q0, bf16x8 q1,
                                          const float* btab_h, int dbase, int cmin, int cmax, float sink, int fr, int fq, f32x4 (&o)[4]) {
    f32x4 s[10];
#pragma unroll
    for (int kb = 0; kb < 10; ++kb) {
        const unsigned char* kr = Ks + (16 * (kb0 + kb) + fr) * 144 + 16 * fq;
        bf16x8 a0 = *(const bf16x8*)kr, a1 = *(const bf16x8*)(kr + 64);
        f32x4 z = (f32x4){0.f, 0.f, 0.f, 0.f};
        z = mfma16(a0, q0, z); z = mfma16(a1, q1, z);
        s[kb] = z;
        if (kb == 4) __builtin_amdgcn_sched_barrier(0);
    }
    float m = sink;
#pragma unroll
    for (int kb = 0; kb < 10; ++kb)
#pragma unroll
        for (int jj = 0; jj < 4; ++jj) {
            const int c = 16 * (kb0 + kb) + 4 * fq + jj; const int dist = dbase - c;
            const bool valid = dist >= 0 && dist < 128 && c >= cmin && c < cmax;
            const float bias = btab_h[dist & 127];
            const float sv = valid ? s[kb][jj] * 0.125f + bias : -1e30f;
            s[kb][jj] = sv; m = fmaxf(m, sv);
        }
    m = fmaxf(m, __shfl_xor(m, 16)); m = fmaxf(m, __shfl_xor(m, 32));
    float l = 0.f;
#pragma unroll
    for (int kb = 0; kb < 10; ++kb)
#pragma unroll
        for (int jj = 0; jj < 4; ++jj) { const float sv = s[kb][jj]; const float pe = sv > -1e29f ? __expf(sv - m) : 0.f; s[kb][jj] = pe; l += pe; }
    l += __shfl_xor(l, 16); l += __shfl_xor(l, 32);
    l += __expf(sink - m);
    const float inv = 1.0f / l;
    bf16x8 pb[5];
#pragma unroll
    for (int kk = 0; kk < 5; ++kk) {
        u32x4 w; w.x = pk_bf16(s[2 * kk][0], s[2 * kk][1]); w.y = pk_bf16(s[2 * kk][2], s[2 * kk][3]); w.z = pk_bf16(s[2 * kk + 1][0], s[2 * kk + 1][1]); w.w = pk_bf16(s[2 * kk + 1][2], s[2 * kk + 1][3]);
        pb[kk] = __builtin_bit_cast(bf16x8, w);
    }
#pragma unroll
    for (int db = 0; db < 4; ++db) {
        f32x4 z = (f32x4){0.f, 0.f, 0.f, 0.f};
#pragma unroll
        for (int kk = 0; kk < 5; ++kk) {
            const unsigned char* vr = Vt + (16 * db + fr) * vstride + (16 * (kb0 + 2 * kk) + 4 * fq) * 2;
            u32x2 lo = *(const u32x2*)vr, hi = *(const u32x2*)(vr + 32);
            u32x4 w; w.x = lo.x; w.y = lo.y; w.z = hi.x; w.w = hi.y;
            z = mfma16(__builtin_bit_cast(bf16x8, w), pb[kk], z);
        }
        o[db] = z * inv;
    }
}
__device__ __forceinline__ void attn_core_l2(const unsigned char* Ks, const unsigned char* Vt, int vstride, int kb0, bf16x8 q0, bf16x8 q1,
                                          const float* btab_h, int dbase, int cmin, int cmax, float sink, int fr, int fq, f32x4 (&o)[4]) {
    f32x4 s[10];
#pragma unroll
    for (int kb = 0; kb < 10; ++kb) {
        const unsigned char* kr = Ks + (16 * (kb0 + kb) + fr) * 144 + 16 * fq;
        bf16x8 a0 = *(const bf16x8*)kr, a1 = *(const bf16x8*)(kr + 64);
        f32x4 z = (f32x4){0.f, 0.f, 0.f, 0.f};
        z = mfma16(a0, q0, z); z = mfma16(a1, q1, z);
        s[kb] = z;
        if (kb == 4) __builtin_amdgcn_sched_barrier(0);
    }
    float m = sink;
#pragma unroll
    for (int kb = 0; kb < 10; ++kb)
#pragma unroll
        for (int jj = 0; jj < 4; ++jj) {
            const int c = 16 * (kb0 + kb) + 4 * fq + jj; const int dist = dbase - c;
            const bool valid = dist >= 0 && dist < 128 && c >= cmin && c < cmax;
            const float bias = btab_h[dist & 127];
            const float sv = valid ? s[kb][jj] * 0.18033688f + bias : -1e30f;
            s[kb][jj] = sv; m = fmaxf(m, sv);
        }
    m = fmaxf(m, __shfl_xor(m, 16)); m = fmaxf(m, __shfl_xor(m, 32));
    float l = 0.f;
#pragma unroll
    for (int kb = 0; kb < 10; ++kb)
#pragma unroll
        for (int jj = 0; jj < 4; ++jj) { const float pe = __builtin_amdgcn_exp2f(s[kb][jj] - m); s[kb][jj] = pe; l += pe; }
    l += __shfl_xor(l, 16); l += __shfl_xor(l, 32);
    l += __builtin_amdgcn_exp2f(sink - m);
    const float inv = 1.0f / l;
    bf16x8 pb[5];
#pragma unroll
    for (int kk = 0; kk < 5; ++kk) {
        u32x4 w; w.x = pk_bf16(s[2 * kk][0], s[2 * kk][1]); w.y = pk_bf16(s[2 * kk][2], s[2 * kk][3]); w.z = pk_bf16(s[2 * kk + 1][0], s[2 * kk + 1][1]); w.w = pk_bf16(s[2 * kk + 1][2], s[2 * kk + 1][3]);
        pb[kk] = __builtin_bit_cast(bf16x8, w);
    }
#pragma unroll
    for (int db = 0; db < 4; ++db) {
        f32x4 z = (f32x4){0.f, 0.f, 0.f, 0.f};
#pragma unroll
        for (int kk = 0; kk < 5; ++kk) {
            const unsigned char* vr = Vt + (16 * db + fr) * vstride + (16 * (kb0 + 2 * kk) + 4 * fq) * 2;
            u32x2 lo = *(const u32x2*)vr, hi = *(const u32x2*)(vr + 32);
            u32x4 w; w.x = lo.x; w.y = lo.y; w.z = hi.x; w.w = hi.y;
            z = mfma16(__builtin_bit_cast(bf16x8, w), pb[kk], z);
        }
        o[db] = z * inv;
    }
}
__device__ __forceinline__ void attn_core_9(const unsigned char* Ks, const unsigned char* Vt, int vstride, int kb0, bf16x8 q0, bf16x8 q1,
                                          const float* btab_h, int dbase, int cmin, int cmax, float sink, int fr, int fq, f32x4 (&o)[4]) {
    f32x4 s[9];
#pragma unroll
    for (int kb = 0; kb < 9; ++kb) {
        const unsigned char* kr = Ks + (16 * (kb0 + kb) + fr) * 144 + 16 * fq;
        bf16x8 a0 = *(const bf16x8*)kr, a1 = *(const bf16x8*)(kr + 64);
        f32x4 z = (f32x4){0.f, 0.f, 0.f, 0.f};
        z = mfma16(a0, q0, z); z = mfma16(a1, q1, z);
        s[kb] = z;
        if (kb == 4) __builtin_amdgcn_sched_barrier(0);
    }
    float m = sink;
#pragma unroll
    for (int kb = 0; kb < 9; ++kb)
#pragma unroll
        for (int jj = 0; jj < 4; ++jj) {
            const int c = 16 * (kb0 + kb) + 4 * fq + jj; const int dist = dbase - c;
            const bool valid = dist >= 0 && dist < 128 && c >= cmin && c < cmax;
            const float bias = btab_h[dist & 127];
            const float sv = valid ? s[kb][jj] * 0.18033688f + bias : -1e30f;
            s[kb][jj] = sv; m = fmaxf(m, sv);
        }
    m = fmaxf(m, __shfl_xor(m, 16)); m = fmaxf(m, __shfl_xor(m, 32));
    float l = 0.f;
#pragma unroll
    for (int kb = 0; kb < 9; ++kb)
#pragma unroll
        for (int jj = 0; jj < 4; ++jj) { const float pe = __builtin_amdgcn_exp2f(s[kb][jj] - m); s[kb][jj] = pe; l += pe; }
    l += __shfl_xor(l, 16); l += __shfl_xor(l, 32);
    l += __builtin_amdgcn_exp2f(sink - m);
    const float inv = 1.0f / l;
    bf16x8 pb[4];
#pragma unroll
    for (int kk = 0; kk < 4; ++kk) {
        u32x4 w; w.x = pk_bf16(s[2 * kk][0], s[2 * kk][1]); w.y = pk_bf16(s[2 * kk][2], s[2 * kk][3]); w.z = pk_bf16(s[2 * kk + 1][0], s[2 * kk + 1][1]); w.w = pk_bf16(s[2 * kk + 1][2], s[2 * kk + 1][3]);
        pb[kk] = __builtin_bit_cast(bf16x8, w);
    }
    u32x4 w8; w8.x = pk_bf16(s[8][0], s[8][1]); w8.y = pk_bf16(s[8][2], s[8][3]); w8.z = 0u; w8.w = 0u;
    const bf16x8 pb8 = __builtin_bit_cast(bf16x8, w8);
#pragma unroll
    for (int db = 0; db < 4; ++db) {
        f32x4 z = (f32x4){0.f, 0.f, 0.f, 0.f};
#pragma unroll
        for (int kk = 0; kk < 4; ++kk) {
            const unsigned char* vr = Vt + (16 * db + fr) * vstride + (16 * (kb0 + 2 * kk) + 4 * fq) * 2;
            u32x2 lo = *(const u32x2*)vr, hi = *(const u32x2*)(vr + 32);
            u32x4 w; w.x = lo.x; w.y = lo.y; w.z = hi.x; w.w = hi.y;
            z = mfma16(__builtin_bit_cast(bf16x8, w), pb[kk], z);
        }
        { const u32x2 lo = *(const u32x2*)(Vt + (16 * db + fr) * vstride + (16 * (kb0 + 8) + 4 * fq) * 2); u32x4 w; w.x = lo.x; w.y = lo.y; w.z = lo.x; w.w = lo.y; z = mfma16(__builtin_bit_cast(bf16x8, w), pb8, z); }
        o[db] = z * inv;
    }
}
__device__ __forceinline__ void attn_core_h(const unsigned char* Ks, const unsigned char* Vt, int vstride, int kb0, bf16x8 q0, bf16x8 q1,
                                          const float (&be)[9][4], int cmin, float sink, int fr, int fq, f32x4 (&o)[4]) {
    f32x4 s[9];
#pragma unroll
    for (int kb = 0; kb < 9; ++kb) {
        const unsigned char* kr = Ks + (16 * (kb0 + kb) + fr) * 144 + 16 * fq;
        bf16x8 a0 = *(const bf16x8*)kr, a1 = *(const bf16x8*)(kr + 64);
        f32x4 z = (f32x4){0.f, 0.f, 0.f, 0.f};
        z = mfma16(a0, q0, z); z = mfma16(a1, q1, z);
        s[kb] = z;
        if (kb == 4) __builtin_amdgcn_sched_barrier(0);
    }
    float m = sink;
#pragma unroll
    for (int kb = 0; kb < 9; ++kb)
#pragma unroll
        for (int jj = 0; jj < 4; ++jj) {
            const int c = 16 * (kb0 + kb) + 4 * fq + jj;
            const float sv0 = __builtin_fmaf(s[kb][jj], 0.18033688f, be[kb][jj]);
            const float sv = c >= cmin ? sv0 : -1e30f;
            s[kb][jj] = sv; m = fmaxf(m, sv);
        }
    m = fmaxf(m, __shfl_xor(m, 16)); m = fmaxf(m, __shfl_xor(m, 32));
    float l = 0.f;
#pragma unroll
    for (int kb = 0; kb < 9; ++kb)
#pragma unroll
        for (int jj = 0; jj < 4; ++jj) { const float pe = __builtin_amdgcn_exp2f(s[kb][jj] - m); s[kb][jj] = pe; l += pe; }
    l += __shfl_xor(l, 16); l += __shfl_xor(l, 32);
    l += __builtin_amdgcn_exp2f(sink - m);
    const float inv = 1.0f / l;
    bf16x8 pb[4];
#pragma unroll
    for (int kk = 0; kk < 4; ++kk) {
        u32x4 w; w.x = pk_bf16(s[2 * kk][0], s[2 * kk][1]); w.y = pk_bf16(s[2 * kk][2], s[2 * kk][3]); w.z = pk_bf16(s[2 * kk + 1][0], s[2 * kk + 1][1]); w.w = pk_bf16(s[2 * kk + 1][2], s[2 * kk + 1][3]);
        pb[kk] = __builtin_bit_cast(bf16x8, w);
    }
    u32x4 w8; w8.x = pk_bf16(s[8][0], s[8][1]); w8.y = pk_bf16(s[8][2], s[8][3]); w8.z = 0u; w8.w = 0u;
    const bf16x8 pb8 = __builtin_bit_cast(bf16x8, w8);
#pragma unroll
    for (int db = 0; db < 4; ++db) {
        f32x4 z = (f32x4){0.f, 0.f, 0.f, 0.f};
#pragma unroll
        for (int kk = 0; kk < 4; ++kk) {
            const unsigned char* vr = Vt + (16 * db + fr) * vstride + (16 * (kb0 + 2 * kk) + 4 * fq) * 2;
            u32x2 lo = *(const u32x2*)vr, hi = *(const u32x2*)(vr + 32);
            u32x4 w; w.x = lo.x; w.y = lo.y; w.z = hi.x; w.w = hi.y;
            z = mfma16(__builtin_bit_cast(bf16x8, w), pb[kk], z);
        }
        { const u32x2 lo = *(const u32x2*)(Vt + (16 * db + fr) * vstride + (16 * (kb0 + 8) + 4 * fq) * 2); u32x4 w; w.x = lo.x; w.y = lo.y; w.z = lo.x; w.w = lo.y; z = mfma16(__builtin_bit_cast(bf16x8, w), pb8, z); }
        o[db] = z * inv;
    }
}

__device__ __forceinline__ void attn_phase(const int wv, const Params& p, int j, unsigned char* lds) {
    asm volatile("; ==== PHASE attn");
    const int tid = opaque_tid(wv), wid = tid >> 6, lane = tid & 63, fr = lane & 15, fq = lane >> 4;
    int bid = blockIdx.x; asm volatile("" : "+s"(bid));
    u32x4 kreg[4], vreg[4];
    auto kv_load = [&](int u) {
        const int b = u >> 7, n = (u >> 2) & 31, kvh = u & 3;
        {   const int row = tid >> 1, half = tid & 1;
            const long tok = (long)b * 4096 + (long)(n - 1) * 128 + row;
            const bool ok = !(n == 0 && row < 128);
            const u32x4* src = (const u32x4*)(p.k() + (ok ? tok : 0) * 256 + kvh * 64 + half * 32);
#pragma unroll
            for (int i = 0; i < 4; ++i) { const u32x4 w = src[i]; kreg[i] = ok ? w : w ^ w; } }
        {   const int key = tid & 255, dp = tid >> 8;
            const long tok = (long)b * 4096 + (long)(n - 1) * 128 + key;
            const bool ok = !(n == 0 && key < 128);
            const u32x4* src = (const u32x4*)(p.v() + (ok ? tok : 0) * 256 + kvh * 64 + dp * 32);
#pragma unroll
            for (int i = 0; i < 4; ++i) { const u32x4 w = src[i]; vreg[i] = ok ? w : w ^ w; } }
    };
    if (bid < 512) kv_load(bid);
    int u = bid;
    for (; u < 512; u += gridDim.x) {
        {
            const int b = u >> 7, n = (u >> 2) & 31, kvh = u & 3;
            unsigned char* Ks = lds; unsigned char* Vt = lds + 36864; float* btab = (float*)(lds + 70656);
            const int g = wid & 3, qh = wid >> 2, head = kvh * 4 + g;
            const bf16_t* qbase = p.q() + ((long)b * 4096 + n * 128 + 64 * qh + fr) * 1024 + head * 64 + 8 * fq;
            bf16x8 q0 = *(const bf16x8*)qbase, q1 = *(const bf16x8*)(qbase + 32);
            {   const int row = tid >> 1, half = tid & 1;
                u32x4* dst = (u32x4*)(Ks + row * 144 + half * 64);
#pragma unroll
                for (int i = 0; i < 4; ++i) dst[i] = kreg[i]; }
            {   const int key = tid & 255, dp = tid >> 8;
#pragma unroll
                for (int i = 0; i < 4; ++i) {
                    const u32x4 w = vreg[i];
                    bf16_t* dst = (bf16_t*)(Vt + (dp * 32 + 8 * i) * 528 + key * 2);
#pragma unroll
                    for (int e = 0; e < 4; ++e) { dst[(2 * e) * 264] = (bf16_t)(w[e] & 0xffffu); dst[(2 * e + 1) * 264] = (bf16_t)(w[e] >> 16); }
                } }
            { const int hl = tid >> 7, dist = tid & 127; btab[hl * 128 + dist] = p.rel_bias[kBucket[dist] * 16 + kvh * 4 + hl] * 1.44269504f; }
            lds_barrier();
            if (u + (int)gridDim.x < 512) kv_load(u + (int)gridDim.x);
            const float sink = p.sinks[j * 16 + head] * 1.44269504f;
            float be[9][4];
#pragma unroll
            for (int kb = 0; kb < 9; ++kb)
#pragma unroll
                for (int jj = 0; jj < 4; ++jj) { const int dist = 128 + fr - 16 * kb - 4 * fq - jj; const float bv = btab[g * 128 + (dist & 127)]; be[kb][jj] = (dist >= 0 && dist < 128) ? bv : -1e30f; }
#pragma unroll 1
            for (int qb = 0; qb < 4; ++qb) {
                const int r0 = 64 * qh + 16 * qb;
                const long tokq = (long)b * 4096 + n * 128 + r0 + fr;
                const int a = r0 >> 4; const int kb0 = a;
                const bf16_t* qn = qbase + (long)(qb < 3 ? 16 * (qb + 1) : 0) * 1024;
                const bf16x8 n0 = *(const bf16x8*)qn, n1 = *(const bf16x8*)(qn + 32);
                __builtin_amdgcn_sched_barrier(0);
                f32x4 o[4];
                attn_core_h(Ks, Vt, 528, kb0, q0, q1, be, n == 0 ? 128 : 0, sink, fr, fq, o);
#pragma unroll
                for (int db = 0; db < 4; ++db) { u32x2 w; w.x = pk_bf16(o[db][0], o[db][1]); w.y = pk_bf16(o[db][2], o[db][3]); *(u32x2*)(p.o() + tokq * 1024 + head * 64 + 16 * db + 4 * fq) = w; }
                q0 = n0; q1 = n1;
            }
            lds_barrier();
        }
    }
    for (; u < 768; u += gridDim.x) {
        {
            const int su = u - 512, b = su >> 1, kvp = su & 1;
            float* btab = (float*)(lds + 89088);
#pragma unroll
            for (int ib = 0; ib < 2; ++ib) {
                f32x4 kxs[4], vxs[4];
#pragma unroll
                for (int ii = 0; ii < 4; ++ii) {
                    const int e = tid + 512 * (4 * ib + ii); const int kl = e >> 11, c = (e >> 4) & 127, d = (e & 15) * 4;
                    const long off = ((long)(j * 128 + b) * 128 + c) * 256 + (2 * kvp + kl) * 64 + d;
                    kxs[ii] = __builtin_nontemporal_load((const f32x4*)(p.cache_k + off)); vxs[ii] = __builtin_nontemporal_load((const f32x4*)(p.cache_v + off));
                }
                __builtin_amdgcn_sched_barrier(0);
#pragma unroll
                for (int ii = 0; ii < 4; ++ii) {
                    const int e = tid + 512 * (4 * ib + ii); const int kl = e >> 11, c = (e >> 4) & 127, d = (e & 15) * 4;
                    const long off = ((long)(j * 128 + b) * 128 + c) * 256 + (2 * kvp + kl) * 64 + d;
                    const f32x4 kx = kxs[ii], vx = vxs[ii];
                    u32x2 w; w.x = pk_bf16(kx[0], kx[1]); w.y = pk_bf16(kx[2], kx[3]);
                    *(u32x2*)(lds + kl * 44544 + c * 144 + d * 2) = w;
                    bf16_t* vd = (bf16_t*)(lds + kl * 44544 + 23040 + d * 336 + c * 2);
                    vd[0] = f2bf(vx[0]); vd[168] = f2bf(vx[1]); vd[336] = f2bf(vx[2]); vd[504] = f2bf(vx[3]);
                }
            }
            {
                const int kl = tid >> 8, cc = (tid >> 6) & 3, d = tid & 63;
                const long tok = TP + b * 4 + cc;
                *(bf16_t*)(lds + kl * 44544 + (128 + cc) * 144 + d * 2) = p.k()[tok * 256 + (2 * kvp + kl) * 64 + d];
                *(bf16_t*)(lds + kl * 44544 + 23040 + d * 336 + (128 + cc) * 2) = p.v()[tok * 256 + (2 * kvp + kl) * 64 + d];
            }
            for (int e = tid; e < 2 * 28 * 64; e += NTHREADS) {
                const int kl = e / (28 * 64), r = e % (28 * 64), c = 132 + r / 64, d = r % 64;
                *(bf16_t*)(lds + kl * 44544 + c * 144 + d * 2) = 0;
                *(bf16_t*)(lds + kl * 44544 + 23040 + d * 336 + c * 2) = 0;
            }
            for (int e = tid; e < 1024; e += NTHREADS) { const int hl = e >> 7, dist = e & 127; btab[e] = p.rel_bias[kBucket[dist] * 16 + kvp * 8 + hl]; }
            lds_barrier();
            if (wid < 2) {
                const int kl = wid, kvh = 2 * kvp + kl, g = fr >> 2, jt = fr & 3, head = kvh * 4 + g;
                const long tok = TP + b * 4 + jt;
                const bf16_t* qp = p.q() + tok * 1024 + head * 64 + 8 * fq;
                bf16x8 q0 = *(const bf16x8*)qp, q1 = *(const bf16x8*)(qp + 32);
                const float sink = p.sinks[j * 16 + head];
                f32x4 o[4];
                attn_core(lds + kl * 44544, lds + kl * 44544 + 23040, 336, 0, q0, q1, btab + (kl * 4 + g) * 128, jt + 128, 0, 132, sink, fr, fq, o);
#pragma unroll
                for (int db = 0; db < 4; ++db) { u32x2 w; w.x = pk_bf16(o[db][0], o[db][1]); w.y = pk_bf16(o[db][2], o[db][3]); *(u32x2*)(p.o() + tok * 1024 + head * 64 + 16 * db + 4 * fq) = w; }
            }
            lds_barrier();
        }
    }
}

__device__ __forceinline__ void convz_phase(const int wv, const Params& p, int j) {
    asm volatile("; ==== PHASE convz");
    const float* cw = p.conv_w + j * 3 * 1024;
    const int tid = opaque_tid(wv);
    const int c8 = (tid & 127) * 8;
    float w0[8], w1[8], w2[8];
#pragma unroll
    for (int i = 0; i < 8; ++i) { w0[i] = cw[c8 + i]; w1[i] = cw[1024 + c8 + i]; w2[i] = cw[2048 + c8 + i]; }
    const long S = (long)gridDim.x * 4;
    for (long t0 = (long)blockIdx.x * 4 + (tid >> 7); t0 < TP; t0 += 4 * S) {
        u32x4 bw[4], u0[4], r1[4], r2[4];
#pragma unroll
        for (int q = 0; q < 4; ++q) {
            const long t = t0 + q * S, tc = t < TP ? t : TP - 1; const int s = (int)(tc & 4095);
            bw[q] = *(const u32x4*)(p.bg() + tc * 1024 + c8);
            u0[q] = *(const u32x4*)(p.ub() + tc * 1024 + c8);
            r1[q] = *(const u32x4*)(p.ub() + (tc - (s >= 1 ? 1 : 0)) * 1024 + c8);
            r2[q] = *(const u32x4*)(p.ub() + (tc - (s >= 2 ? 2 : 0)) * 1024 + c8);
        }
#pragma unroll
        for (int q = 0; q < 4; ++q) {
            const long t = t0 + q * S;
            if (t < TP) {
                const int s = (int)(t & 4095); const float m1 = s >= 1 ? 1.f : 0.f, m2 = s >= 2 ? 1.f : 0.f;
                float z[8];
#pragma unroll
                for (int i = 0; i < 8; ++i) {
                    const float uu = (i & 1) ? bfhi(u0[q][i >> 1]) : bflo(u0[q][i >> 1]);
                    const float bb = (i & 1) ? bfhi(bw[q][i >> 1]) : bflo(bw[q][i >> 1]);
                    const float a1 = ((i & 1) ? bfhi(r1[q][i >> 1]) : bflo(r1[q][i >> 1])) * m1;
                    const float a2 = ((i & 1) ? bfhi(r2[q][i >> 1]) : bflo(r2[q][i >> 1])) * m2;
                    z[i] = bb * (w0[i] * a2 + w1[i] * a1 + w2[i] * uu);
                }
                u32x4 w; w.x = pk_bf16(z[0], z[1]); w.y = pk_bf16(z[2], z[3]); w.z = pk_bf16(z[4], z[5]); w.w = pk_bf16(z[6], z[7]);
                *(u32x4*)(p.o() + t * 1024 + c8) = w;
            }
        }
    }
    for (long t = (long)TP + (long)blockIdx.x * 4 + (tid >> 7); t < T; t += (long)gridDim.x * 4) {
        u32x4 bw = *(const u32x4*)(p.bg() + t * 1024 + c8);
        u32x4 u0 = *(const u32x4*)(p.ub() + t * 1024 + c8);
        float u1[8], u2[8];
        bool h1, h2; const float *s1 = nullptr, *s2 = nullptr;
        if (t < TP) { const int s = (int)(t & 4095); h1 = s >= 1; h2 = s >= 2; }
        else { const long ts = t - TP; const int jt = (int)(ts & 3); const float* st = p.state_conv + ((long)(j * 128 + (ts >> 2)) * 2) * 1024 + c8;
               h1 = jt >= 1; h2 = jt >= 2; if (jt == 0) { s1 = st + 1024; s2 = st; } else if (jt == 1) { s2 = st + 1024; } }
        if (h1) { u32x4 w = *(const u32x4*)(p.ub() + (t - 1) * 1024 + c8);
#pragma unroll
            for (int i = 0; i < 4; ++i) { u1[2 * i] = bflo(w[i]); u1[2 * i + 1] = bfhi(w[i]); } }
        else if (s1) { f32x4 a = *(const f32x4*)s1, b = *(const f32x4*)(s1 + 4);
#pragma unroll
            for (int i = 0; i < 4; ++i) { u1[i] = a[i]; u1[4 + i] = b[i]; } }
        else {
#pragma unroll
            for (int i = 0; i < 8; ++i) u1[i] = 0.f; }
        if (h2) { u32x4 w = *(const u32x4*)(p.ub() + (t - 2) * 1024 + c8);
#pragma unroll
            for (int i = 0; i < 4; ++i) { u2[2 * i] = bflo(w[i]); u2[2 * i + 1] = bfhi(w[i]); } }
        else if (s2) { f32x4 a = *(const f32x4*)s2, b = *(const f32x4*)(s2 + 4);
#pragma unroll
            for (int i = 0; i < 4; ++i) { u2[i] = a[i]; u2[4 + i] = b[i]; } }
        else {
#pragma unroll
            for (int i = 0; i < 8; ++i) u2[i] = 0.f; }
        float z[8];
#pragma unroll
        for (int i = 0; i < 8; ++i) {
            const float uu = (i & 1) ? bfhi(u0[i >> 1]) : bflo(u0[i >> 1]);
            const float bb = (i & 1) ? bfhi(bw[i >> 1]) : bflo(bw[i >> 1]);
            z[i] = bb * (w0[i] * u2[i] + w1[i] * u1[i] + w2[i] * uu);
        }
        u32x4 w; w.x = pk_bf16(z[0], z[1]); w.y = pk_bf16(z[2], z[3]); w.z = pk_bf16(z[4], z[5]); w.w = pk_bf16(z[6], z[7]);
        *(u32x4*)(p.o() + t * 1024 + c8) = w;
    }
}

__device__ __forceinline__ int f2sort(float f) { int b = __float_as_int(f); return b ^ ((b >> 31) & 0x7fffffff); }
__device__ __forceinline__ float sort2f(int s) { return __int_as_float(s ^ ((s >> 31) & 0x7fffffff)); }
__device__ __forceinline__ int shx16(int v, bool oddrow) { const auto r = __builtin_amdgcn_permlane16_swap((unsigned)v, (unsigned)v, false, false); return oddrow ? (int)r[0] : (int)r[1]; }
__device__ __forceinline__ int shx32(int v, bool hi) { const auto r = __builtin_amdgcn_permlane32_swap((unsigned)v, (unsigned)v, false, false); return hi ? (int)r[0] : (int)r[1]; }
#define CE_DESC(a, b) { int _hi = max(a, b), _lo = min(a, b); a = _hi; b = _lo; }
__device__ __forceinline__ void bitonic_merge16(int (&a)[16]) {
#pragma unroll
    for (int jj = 8; jj >= 1; jj >>= 1)
#pragma unroll
        for (int i = 0; i < 16; ++i) { const int l = i ^ jj; if (l > i) CE_DESC(a[i], a[l]); }
}
__device__ __forceinline__ void bitonic_sort16(int (&a)[16]) {
#pragma unroll
    for (int k = 2; k <= 16; k <<= 1)
#pragma unroll
        for (int jj = k >> 1; jj >= 1; jj >>= 1)
#pragma unroll
            for (int i = 0; i < 16; ++i) {
                const int l = i ^ jj;
                if (l > i) { if ((i & k) == 0 || k == 16) { CE_DESC(a[i], a[l]); } else { CE_DESC(a[l], a[i]); } }
            }
}
constexpr unsigned char cOE16[126] = {0,1,2,3,0,2,1,3,1,2,4,5,6,7,4,6,5,7,5,6,0,4,2,6,2,4,1,5,3,7,3,5,1,2,3,4,5,6,8,9,10,11,8,10,9,11,9,10,12,13,14,15,12,14,13,15,13,14,8,12,10,14,10,12,9,13,11,15,11,13,9,10,11,12,13,14,0,8,4,12,4,8,2,10,6,14,6,10,2,4,6,8,10,12,1,9,5,13,5,9,3,11,7,15,7,11,3,5,7,9,11,13,1,2,3,4,5,6,7,8,9,10,11,12,13,14};
__device__ __forceinline__ void oe_sort16(int (&a)[16]) {
#pragma unroll
    for (int c = 0; c < 63; ++c) CE_DESC(a[cOE16[2 * c]], a[cOE16[2 * c + 1]]);
}
__device__ __attribute__((aligned(16))) const unsigned char kCand[64] = {0,4,8,12,16,20,32,36,51,80,112,160,224,255,255,255,1,5,9,13,17,21,33,48,64,81,113,176,240,255,255,255,2,6,10,14,18,22,34,49,65,96,128,192,255,255,255,255,3,7,11,15,19,23,35,50,66,97,144,208,255,255,255,255};
__device__ const unsigned char kPI[64] = {0,0,0,0,0,0,0,0,0,0,0,0,0,0,0,0,1,1,1,1,1,1,1,1,2,2,2,2,2,3,3,3,3,4,4,4,5,5,6,6,7,7,8,9,10,11,12,13,14,15,0,0,0,0,0,0,0,0,0,0,0,0,0,0};
__device__ const unsigned char kPJ[64] = {0,1,2,3,4,5,6,7,8,9,10,11,12,13,14,15,0,1,2,3,4,5,6,7,0,1,2,3,4,0,1,2,3,0,1,2,0,1,0,1,0,1,0,0,0,0,0,0,0,0,0,0,0,0,0,0,0,0,0,0,0,0,0,0};
constexpr unsigned char cPI[64] = {0,0,0,0,0,0,0,0,0,0,0,0,0,0,0,0,1,1,1,1,1,1,1,1,2,2,2,2,2,3,3,3,3,4,4,4,5,5,6,6,7,7,8,9,10,11,12,13,14,15,0,0,0,0,0,0,0,0,0,0,0,0,0,0};
constexpr unsigned char cPJ[64] = {0,1,2,3,4,5,6,7,8,9,10,11,12,13,14,15,0,1,2,3,4,5,6,7,0,1,2,3,4,0,1,2,3,0,1,2,0,1,0,1,0,1,0,0,0,0,0,0,0,0,0,0,0,0,0,0,0,0,0,0,0,0,0,0};

__device__ __forceinline__ void peer_scores_topk(const int tid, int* const sel_idx, float* const sel_g, float* const sel_su, const float* const SU, const float* const SV, const int head, const long trow0, unsigned char* lds, const int skbase, const int xlbase) {
    const int wid = tid >> 6, lane = tid & 63, fr = lane & 15, fq = lane >> 4;
    int* fl = (int*)(lds + xlbase);
    const int rowmine = 16 * wid + fr;
    int mine[2][16];
#pragma unroll
    for (int pp = 0; pp < 2; ++pp) {
        f32x4 sc[8];
#pragma unroll
        for (int n = 0; n < 8; ++n) sc[n] = (f32x4){0.f, 0.f, 0.f, 0.f};
#pragma unroll
        for (int kh = 0; kh < 2; ++kh) {
            const unsigned char* Ab = lds + (pp * 2 + kh) * 16384;
            const unsigned char* Bb = lds + skbase + (pp * 2 + kh) * 16384;
#pragma unroll
            for (int k = 0; k < 2; ++k) {
                const bf16x8 a = *(const bf16x8*)(Ab + lds_byte(rowmine, 32 * k + 8 * fq));
#pragma unroll
                for (int n = 0; n < 8; ++n) sc[n] = mfma16(*(const bf16x8*)(Bb + lds_byte(16 * n + fr, 32 * k + 8 * fq)), a, sc[n]);
            }
        }
        int LB[16];
#pragma unroll
        for (int n = 0; n < 4; ++n)
#pragma unroll
            for (int jj = 0; jj < 4; ++jj) {
                mine[pp][4 * n + jj] = ((int)sc[n][jj] & ~127) | (16 * n + 4 * fq + jj);
                LB[4 * n + jj] = ((int)sc[4 + n][jj] & ~127) | (64 + 16 * n + 4 * fq + jj);
            }
        oe_sort16(mine[pp]); oe_sort16(LB);
#pragma unroll
        for (int i = 0; i < 16; ++i) mine[pp][i] = max(mine[pp][i], LB[15 - i]);
        bitonic_merge16(mine[pp]);
#pragma unroll
        for (int lvl = 0; lvl < 2; ++lvl) {
            int bb[16];
#pragma unroll
            for (int i = 0; i < 16; ++i) bb[i] = lvl == 0 ? shx16(mine[pp][15 - i], fq & 1) : shx32(mine[pp][15 - i], fq >> 1);
#pragma unroll
            for (int i = 0; i < 16; ++i) mine[pp][i] = max(mine[pp][i], bb[i]);
            bitonic_merge16(mine[pp]);
        }
        if (fq == 0) {
#pragma unroll
            for (int i = 0; i < 16; ++i) fl[rowmine * 32 + pp * 16 + i] = mine[pp][i];
        }
    }
    int C[16];
    {
        const u32x4 cw = *(const u32x4*)(kCand + fq * 16);
#pragma unroll
        for (int slot = 0; slot < 13; ++slot) {
            const int code = (int)((cw[slot >> 2] >> (8 * (slot & 3))) & 255u);
            const int ka = fl[rowmine * 32 + (code >> 4)], kb = fl[rowmine * 32 + 16 + (code & 15)];
            const int sum = (ka & ~127) + (kb & ~127);
            C[slot] = code != 255 ? ((sum & ~255) | code) : (int)0x80000000;
        }
        C[13] = C[14] = C[15] = (int)0x80000000;
        oe_sort16(C);
#pragma unroll
        for (int lvl = 0; lvl < 2; ++lvl) {
            int bb[16];
#pragma unroll
            for (int i = 0; i < 16; ++i) bb[i] = lvl == 0 ? shx16(C[15 - i], fq & 1) : shx32(C[15 - i], fq >> 1);
#pragma unroll
            for (int i = 0; i < 16; ++i) C[i] = max(C[i], bb[i]);
            bitonic_merge16(C);
        }
    }
    int c4[4];
#pragma unroll
    for (int i = 0; i < 4; ++i) c4[i] = fq == 0 ? C[i] : fq == 1 ? C[4 + i] : fq == 2 ? C[8 + i] : C[12 + i];
    const int vmax = C[0] & ~255;
    float ev[4]; int eidx[4]; float esum = 0.f;
#pragma unroll
    for (int i = 0; i < 4; ++i) {
        ev[i] = __expf((float)((c4[i] & ~255) - vmax) * (1.0f / PEER_KEY_SCALE)); esum += ev[i];
        const int ai = fl[rowmine * 32 + ((c4[i] >> 4) & 15)] & 127, bj = fl[rowmine * 32 + 16 + (c4[i] & 15)] & 127;
        eidx[i] = ai * 128 + bj;
    }
    esum += __shfl_xor(esum, 16); esum += __shfl_xor(esum, 32);
    const float einv = 1.0f / esum;
    {
        const long t = trow0 + rowmine;
        const f32x4 svv = {SV[eidx[0]], SV[eidx[1]], SV[eidx[2]], SV[eidx[3]]}, suv = {SU[eidx[0]], SU[eidx[1]], SU[eidx[2]], SU[eidx[3]]};
        *(u32x4*)(sel_idx + t * 128 + head * 16 + 4 * fq) = (u32x4){(unsigned)eidx[0], (unsigned)eidx[1], (unsigned)eidx[2], (unsigned)eidx[3]};
        *(f32x4*)(sel_g + t * 128 + head * 16 + 4 * fq) = (f32x4){ev[0] * einv * svv[0], ev[1] * einv * svv[1], ev[2] * einv * svv[2], ev[3] * einv * svv[3]};
        *(f32x4*)(sel_su + t * 128 + head * 16 + 4 * fq) = suv;
    }
    lds_barrier();
}

struct PeerTile {
    static constexpr bool AFTER_DRAIN = true, PERM = false;
    const float* ssq; const bf16_t* sk; int* sel_idx; float* sel_g; float* sel_su; const float* SU; const float* SV; int tid_; unsigned char* lds;
    __device__ __forceinline__ void tile(f32x4 (&acc)[2][2][4][2], int pm, int head, int, int, int, int) const {
        int tid = tid_; asm volatile("" : "+v"(tid));
        const int wid = tid >> 6, lane = tid & 63, wr = wid >> 2, wc = wid & 3, fr = lane & 15, fq = lane >> 4;
        {
            const bf16_t* skh = sk + ((long)head * 2) * 128 * 128;
#pragma unroll
            for (int pp = 0; pp < 2; ++pp)
#pragma unroll
                for (int kh = 0; kh < 2; ++kh) stage_half(skh + (long)pp * 128 * 128, 0, 128, kh * 64, lds + 65536 + (pp * 2 + kh) * 16384, tid);
        }
        u32x2 qp[2][4][2][2];
        float rsv[2][4];
        {
            f32x4 part[2][4];
#pragma unroll
            for (int ai = 0; ai < 2; ++ai)
#pragma unroll
                for (int m = 0; m < 4; ++m) part[ai][m] = row_ssq_q(ssq, (long)pm * 256 + ai * 128 + 64 * wr + 16 * m + fr, fq);
#pragma unroll
            for (int ai = 0; ai < 2; ++ai)
#pragma unroll
                for (int m = 0; m < 4; ++m) rsv[ai][m] = row_rstd_q(part[ai][m]);
        }
#pragma unroll
        for (int ai = 0; ai < 2; ++ai)
#pragma unroll
            for (int m = 0; m < 4; ++m) {
                const float rs = rsv[ai][m];
#pragma unroll
                for (int bj = 0; bj < 2; ++bj)
#pragma unroll
                    for (int n = 0; n < 2; ++n) { const f32x4 v = acc[ai][bj][m][n] * rs; qp[ai][m][bj][n].x = pk_bf16(v[0], v[1]); qp[ai][m][bj][n].y = pk_bf16(v[2], v[3]); }
            }
        half(tid, qp[0], pm, head, 0, wr, wc, fr, fq);
        half(tid, qp[1], pm, head, 1, wr, wc, fr, fq);
    }
    __device__ __forceinline__ void half(const int tid, const u32x2 (&q)[4][2][2], int pm, int head, int ai, int wr, int wc, int fr, int fq) const {
#pragma unroll
        for (int m = 0; m < 4; ++m)
#pragma unroll
            for (int bj = 0; bj < 2; ++bj)
#pragma unroll
                for (int n = 0; n < 2; ++n)
                    *(u32x2*)(lds + (2 * bj + (wc >> 1)) * 16384 + lds_byte(64 * wr + 16 * m + fr, 32 * (wc & 1) + 16 * n + 4 * fq)) = q[m][bj][n];
        full_barrier();
        peer_scores_topk(tid, sel_idx, sel_g, sel_su, SU, SV, head, (long)pm * 256 + ai * 128, lds, 65536, 131072);
    }
};

__device__ __forceinline__ void copy_cache_shift(const Params& p, const int wid, const int lane, const int first, const int stride) {
    constexpr int NROWS = 2 * 128 * 124;
    for (int w0 = (first * 8 + wid) * 4; w0 < NROWS; w0 += stride * 32) {
        f32x4 kx[4], vx[4]; long off[4];
#pragma unroll
        for (int q = 0; q < 4; ++q) {
            const int w = w0 + q < NROWS ? w0 + q : NROWS - 1; const int jb = w / 124, c = w - jb * 124 + 4;
            off[q] = ((long)jb * 128 + c) * 256 + 4 * lane;
            kx[q] = __builtin_nontemporal_load((const f32x4*)(p.cache_k + off[q])); vx[q] = __builtin_nontemporal_load((const f32x4*)(p.cache_v + off[q]));
        }
#pragma unroll
        for (int q = 0; q < 4; ++q)
            if (w0 + q < NROWS) { __builtin_nontemporal_store(kx[q], (f32x4*)(p.out + O_KS + off[q] - 1024)); __builtin_nontemporal_store(vx[q], (f32x4*)(p.out + O_VS + off[q] - 1024)); }
    }
}

__device__ __forceinline__ void peerq_phase(const int wv, const Params& p, int layer, unsigned char* lds, const int gx, const int gt) {
    asm volatile("; ==== PHASE peerq");
    const int tid = opaque_tid(wv), wid = tid >> 6, lane = tid & 63, fr = lane & 15, fq = lane >> 4;
    const bf16_t* Bt = p.wq_t() + (long)layer * 2048 * 1024;
    const bool xmap = (gridDim.x & 7) == 0;
    const int G8 = (int)gridDim.x >> 3;
    for (int xr = 0; xr < (XPROBE == 3 ? 2 : 1); ++xr)
    for (int u = xmap ? gx * 64 + gt : (int)blockIdx.x; u < (xmap ? (gx + 1) * 64 : 512); u += (xmap ? G8 : (int)gridDim.x))
        gemm256_units(tid, (LAS unsigned char*)lds, p.hb(), Bt, 8, u, (int)gridDim.x, u + 1, PeerTile{p.ssq(), p.subk() + ((long)layer * 16) * 128 * 128, p.sel_idx(), p.sel_g(), p.sel_su(), p.su() + layer * 16384, p.sv() + layer * 16384, tid, lds});
    const int us0 = xmap ? (G8 - 1 - gt) * 8 + gx : (int)gridDim.x - 1 - (int)blockIdx.x;
    if (layer < 3) {
        const int nl = layer + 1;
        const int lo = (!(nl & 1) && xmap && (48 % G8) != 0) ? CVT_QKV_UNITS : 0;
        const int nidle = (int)gridDim.x - 32;
        if (nidle > 0) { if (us0 >= 32) convert_tables(p, wid, lane, nl, us0 - 32, nidle, lo, 1024); }
        else convert_tables(p, wid, lane, nl, (int)blockIdx.x, (int)gridDim.x, lo, 1024);
    }
    if (layer == 3) {
        const int nidle = (int)gridDim.x - 32;
        if (nidle > 0) { if (us0 >= 32) copy_cache_shift(p, wid, lane, us0 - 32, nidle); }
        else copy_cache_shift(p, wid, lane, (int)blockIdx.x, (int)gridDim.x);
    }
    for (int xr = 0; xr < (XPROBE == 4 ? 2 : 1); ++xr)
    for (int us = us0; us < 32; us += gridDim.x) {
        const int mt = 128 + (us >> 3), head = us & 7;
        f32x4 acc[4][4];
        gemm_kloop<2>(tid, p.hb(), (long)mt * 128, Bt, (long)head * 256, lds, acc);
        {
            const bf16_t* sk = p.subk() + ((long)(layer * 8 + head) * 2) * 128 * 128;
#pragma unroll
            for (int pp = 0; pp < 2; ++pp)
#pragma unroll
                for (int kh = 0; kh < 2; ++kh) stage_half(sk + (long)pp * 128 * 128, 0, 128, kh * 64, lds + 65536 + (pp * 2 + kh) * 16384, tid);
        }
        {
            const int wr = wid >> 2, wc = wid & 3;
            float rsv[4];
            {
                f32x4 part[4];
#pragma unroll
                for (int m = 0; m < 4; ++m) part[m] = row_ssq_q(p.ssq(), (long)mt * 128 + 64 * wr + 16 * m + fr, fq);
#pragma unroll
                for (int m = 0; m < 4; ++m) rsv[m] = row_rstd_q(part[m]);
            }
#pragma unroll
            for (int m = 0; m < 4; ++m) {
                const int r = 64 * wr + 16 * m + fr; const float rs = rsv[m];
#pragma unroll
                for (int n = 0; n < 4; ++n) { f32x4 v = acc[m][n] * rs; u32x2 w; w.x = pk_bf16(v[0], v[1]); w.y = pk_bf16(v[2], v[3]); *(u32x2*)(lds + wc * 16384 + lds_byte(r, 16 * n + 4 * fq)) = w; }
            }
        }
        full_barrier();
        peer_scores_topk(tid, p.sel_idx(), p.sel_g(), p.sel_su(), p.su() + layer * 16384, p.sv() + layer * 16384, head, (long)mt * 128, lds, 65536, 131072);
    }
}

template <int CTRL> __device__ __forceinline__ float dpp_add(float v) { return v + dpp_f<CTRL>(v); }

__device__ __forceinline__ void g1_phase(const int wv, const Params& p, int layer, unsigned char* lds, const int x, const int tgi) {
    asm volatile("; ==== PHASE g1");
    const int tid = opaque_tid(wv), wid = __builtin_amdgcn_readfirstlane(tid >> 6), lane = tid & 63, r = lane & 15, q = lane >> 4, g8 = lane >> 3, jj = lane & 7;
    const int ntg = gridDim.x >> 3;
    if (tgi >= ntg) return;
    unsigned char* const wl = lds + wid * 19200;
    int* const idxb = (int*)(wl + 16384); float* const xfb = (float*)(wl + 17408); float* const sqb = (float*)(wl + 18432); unsigned char* const xq = wl + 18944;
    const unsigned char* const ws = p.ws;
    const unsigned ubase = (unsigned)(WS_U8 + ((size_t)(layer * 8 + x) * 16384) * 128);
    const int pb = 2 * lane, pjj = pb >> 4, pi = (pb >> 2) & 3, pc = pb & 3;
    const f32x2 gf2 = *(const f32x2*)(p.g_ffn + layer * 1024 + 256 * pi + 32 * x + 4 * pjj + pc) * 8.0f;
    const int ts = ntg * 8, t0 = tgi * 8 + wid;
#define G1_DMA4(src, dst) __builtin_amdgcn_global_load_lds((const unsigned*)(src), (unsigned*)(dst), 4, 0, 0)
#define G1_DMA16(src, dst) __builtin_amdgcn_global_load_lds((const unsigned*)(src), (unsigned*)(dst), 16, 0, 0)
#define G1_WAITV(n) asm volatile("s_waitcnt vmcnt(" #n ")" ::: "memory")
    auto meta = [&](int t, int buf) {
        const int tc = t < T ? t : T - 1;
        G1_DMA4(ws + ((unsigned)WS_SELI + (unsigned)(tc * 128 + lane) * 4u), (unsigned char*)(idxb + buf * 128));
        G1_DMA4(ws + ((unsigned)WS_SELI + (unsigned)(tc * 128 + 64 + lane) * 4u), (unsigned char*)(idxb + buf * 128 + 64));
        G1_DMA4(ws + ((unsigned)WS_HB + (unsigned)(tc * 1024 + 256 * (lane >> 4) + 32 * x + 2 * (lane & 15)) * 2u), (unsigned char*)(xfb + buf * 128));
        G1_DMA4(ws + ((unsigned)WS_SSQ + (unsigned)(tc * 16 + (lane & 15)) * 4u), (unsigned char*)(sqb + buf * 64));
    };
    auto prep = [&](int buf, i32x8& xb) {
        const f32x4 s0 = *(const f32x4*)(sqb + buf * 64), s1 = *(const f32x4*)(sqb + buf * 64 + 4), s2 = *(const f32x4*)(sqb + buf * 64 + 8), s3 = *(const f32x4*)(sqb + buf * 64 + 12);
        const float ssum = ((s0[0] + s0[1]) + (s0[2] + s0[3])) + ((s1[0] + s1[1]) + (s1[2] + s1[3])) + ((s2[0] + s2[1]) + (s2[2] + s2[3])) + ((s3[0] + s3[1]) + (s3[2] + s3[3]));
        const float rs = rsqrtf(ssum * (1.0f / 1024.0f) + EPS);
        const unsigned xw = *(const unsigned*)((const unsigned char*)(xfb + buf * 128) + (32 * pi + 4 * pjj + pc) * 2);
        const float v0 = fminf(fmaxf(bflo(xw) * gf2[0] * rs, -440.f), 440.f), v1 = fminf(fmaxf(bfhi(xw) * gf2[1] * rs, -440.f), 440.f);
        const int ph = __builtin_amdgcn_cvt_pk_fp8_f32(v0, v1, 0, false);
        const f32x2 d = __builtin_amdgcn_cvt_pk_f32_fp8(ph, false);
        const int pl = __builtin_amdgcn_cvt_pk_fp8_f32(v0 - d[0], v1 - d[1], 0, false);
        *(unsigned short*)(xq + pb) = (unsigned short)ph; *(unsigned short*)(xq + 128 + pb) = (unsigned short)pl;
        asm volatile("s_waitcnt lgkmcnt(0)" ::: "memory");
        { const unsigned char* xs = xq + 128 * (r & 1) + 32 * q; const u32x4 h0 = *(const u32x4*)xs, h1 = *(const u32x4*)(xs + 16);
          xb = (i32x8){(int)h0.x, (int)h0.y, (int)h0.z, (int)h0.w, (int)h1.x, (int)h1.y, (int)h1.z, (int)h1.w}; }
        asm volatile("s_waitcnt lgkmcnt(0)" ::: "memory");
    };
    auto lines_q = [&](int buf, int qt) {
        const int* ib = idxb + buf * 128 + 32 * qt;
#pragma unroll
        for (int m = 0; m < 4; ++m) {
            const int row = 8 * m + g8;
            const unsigned off = ubase + (unsigned)ib[row] * 128u + (unsigned)((jj ^ ((row >> 1) & 7)) * 16);
            G1_DMA16(ws + off, wl + qt * 4096 + m * 1024);
        }
    };
    auto frags_q = [&](int qt, i32x8 (&a)[2]) {
        const unsigned char* hb = wl + qt * 4096;
#pragma unroll
        for (int b = 0; b < 2; ++b) {
            const int row = 16 * b + r, f = (row >> 1) & 7;
            const u32x4 lo = *(const u32x4*)(hb + row * 128 + (((2 * q) ^ f) * 16)), hi = *(const u32x4*)(hb + row * 128 + (((2 * q + 1) ^ f) * 16));
            a[b] = (i32x8){(int)lo.x, (int)lo.y, (int)lo.z, (int)lo.w, (int)hi.x, (int)hi.y, (int)hi.z, (int)hi.w};
        }
        asm volatile("s_waitcnt lgkmcnt(0)" ::: "memory");
    };
    auto compute_q = [&](int qt, const i32x8 (&a)[2], const i32x8& xb, f32x4& keep) {
#pragma unroll
        for (int b = 0; b < 2; ++b) {
            f32x4 c = __builtin_amdgcn_mfma_scale_f32_16x16x128_f8f6f4(a[b], xb, (f32x4){0.f, 0.f, 0.f, 0.f}, 0, 0, 0, 0x7f7f7f7f, 0, 0x7f7f7f7f);
            asm("" : "+v"(c) : "v"(a[b]), "v"(xb));
            if (qt == 0 && b == 0) keep = c;
            else {
                const bool mine = (r >> 1) == 2 * qt + b;
#pragma unroll
                for (int e = 0; e < 4; ++e) keep[e] = mine ? c[e] : keep[e];
            }
        }
    };
    auto finish = [&](int t, const f32x4 keep) {
        const unsigned dst = t < T ? (unsigned)WS_PART + (unsigned)((t * 8 + x) * 128 + 16 * (r >> 1) + 4 * q) * 2u : (unsigned)WS_DMY + (unsigned)(lane * 16);
        f32x4 kk;
#pragma unroll
        for (int e = 0; e < 4; ++e) kk[e] = (keep[e] + dpp_f<0xB1>(keep[e])) * 0.125f;
        u32x2 w; w.x = pk_bf16(kk[0], kk[1]); w.y = pk_bf16(kk[2], kk[3]);
        if ((r & 1) == 0) *(u32x2*)(const_cast<unsigned char*>(ws) + dst) = w;
    };
    i32x8 xbA, xbB, fa[2]; f32x4 keep;
    meta(t0, 0); G1_WAITV(0); prep(0, xbA);
    meta(t0 + ts, 1); lines_q(0, 0); lines_q(0, 1); lines_q(0, 2); lines_q(0, 3); keep[0] = keep[1] = keep[2] = keep[3] = gf2[0]; finish(T, keep);
    for (int ta = t0; ta < T; ta += 2 * ts) {
        const int tb = ta + ts;
        meta(ta + 2 * ts, 0);
#pragma unroll
        for (int qt = 0; qt < 4; ++qt) {
            G1_WAITV(16);
            frags_q(qt, fa);
            if (qt == 0) prep(1, xbB);
            lines_q(1, qt);
            compute_q(qt, fa, xbA, keep);
        }
        finish(ta, keep);
        meta(tb + 2 * ts, 1);
#pragma unroll
        for (int qt = 0; qt < 4; ++qt) {
            G1_WAITV(16);
            frags_q(qt, fa);
            if (qt == 0) prep(0, xbA);
            lines_q(0, qt);
            compute_q(qt, fa, xbB, keep);
        }
        finish(tb, keep);
    }
    G1_WAITV(0);
#undef G1_DMA4
#undef G1_DMA16
#undef G1_WAITV
}

__device__ __forceinline__ void g15_phase(const int wv, const Params& p, int layer, float* wout) {
    asm volatile("; ==== PHASE g15");
    const int tid = opaque_tid(wv), wid = tid >> 6, lane = tid & 63;
    const long ts = (long)gridDim.x * 8;
    const unsigned* part = (const unsigned*)(p.ws + WS_PART);
    for (long tb = (long)blockIdx.x * 8 + wid; tb < T; tb += 3 * ts) {
        unsigned pw[3][8]; f32x2 gk[3], su[3];
#pragma unroll
        for (int q = 0; q < 3; ++q) {
            const long t = tb + q * ts, tc = t < T ? t : T - 1;
#pragma unroll
            for (int x = 0; x < 8; ++x) pw[q][x] = __builtin_nontemporal_load(part + ((long)tc * 8 + x) * 64 + lane);
            gk[q] = *(const f32x2*)(p.sel_g() + tc * 128 + 2 * lane); su[q] = *(const f32x2*)(p.sel_su() + tc * 128 + 2 * lane);
        }
#pragma unroll
        for (int q = 0; q < 3; ++q) {
            const long t = tb + q * ts;
            float s0 = 0.f, s1 = 0.f;
#pragma unroll
            for (int x = 0; x < 8; ++x) { s0 += bflo(pw[q][x]); s1 += bfhi(pw[q][x]); }
            f32x2 o;
            { const float hv = s0 * su[q][0]; o[0] = gk[q][0] * (0.5f * hv * (1.0f + erff(hv * 0.70710678118654752f))); }
            { const float hv = s1 * su[q][1]; o[1] = gk[q][1] * (0.5f * hv * (1.0f + erff(hv * 0.70710678118654752f))); }
            if (t < T) *(f32x2*)(wout + t * 128 + 2 * lane) = o;
        }
    }
}

struct G2Meta { int i0, i1; float w0, w1; unsigned hold; };
__device__ __forceinline__ void g2_phase(const int wv, const Params& p, int layer, unsigned char* lds, const bool dry, const int x, const int tgi) {
    asm volatile("; ==== PHASE g2");
    unsigned char* const ws = p.ws;
    const unsigned hbo = dry ? (unsigned)(WS_DMY + (size_t)T * 4096) : (unsigned)WS_HB, sqo = dry ? (unsigned)(WS_DMY + (size_t)T * 6144) : (unsigned)WS_SSQ;
    const int tid = opaque_tid(wv), wid = __builtin_amdgcn_readfirstlane(tid >> 6), lane = tid & 63, g = lane >> 3, jj = lane & 7;
    const int ntg = gridDim.x >> 3;
    if (tgi >= ntg) return;
    int* wbase = (int*)lds + wid * 512;
    const unsigned voff = (unsigned)(WS_V8 + ((size_t)(layer * 8 + x) * 16384) * 128) + (unsigned)jj * 16u;
    const bool b0 = g & 1, b1 = (g >> 1) & 1, b2 = (g >> 2) & 1;
    const int dd = 256 * (2 * (int)b1 + (int)b2) + 32 * x + 4 * jj + 2 * (int)b0;
    const int ts = ntg * 8, t0 = tgi * 8 + wid;
    auto load_meta = [&](int t, G2Meta& m) {
        const int tc = t < T ? t : T - 1;
        const unsigned so = (unsigned)(tc * 128 + lane) * 4u;
        m.i0 = *(const int*)(ws + ((unsigned)WS_SELI + so)); m.i1 = *(const int*)(ws + ((unsigned)WS_SELI + so + 256u));
        m.w0 = *(const float*)(ws + ((unsigned)WS_SELG + so)); m.w1 = *(const float*)(ws + ((unsigned)WS_SELG + so + 256u));
        m.hold = *(const unsigned*)(ws + ((unsigned)WS_HB + (unsigned)(tc * 1024 + dd) * 2u));
    };
    auto write_lds = [&](const G2Meta& m, int buf) {
        int* w = wbase + buf * 256; float* wf = (float*)(w + 128);
        w[lane] = m.i0; w[64 + lane] = m.i1; wf[lane] = m.w0; wf[64 + lane] = m.w1;
        asm volatile("s_waitcnt lgkmcnt(0)" ::: "memory");
    };
    auto issue = [&](int buf, int hf, u32x4 (&ln)[8]) {
        const int* w = wbase + buf * 256 + 64 * hf;
#pragma unroll
        for (int q = 0; q < 8; ++q) { const unsigned off = (unsigned)w[8 * q + g] * 128u + voff; ln[q] = *(const u32x4*)(ws + off); }
    };
    auto finish = [&](int t, const f32x2 (&y)[8], const unsigned hold) {
        float z[8], zz[4], r[2];
#pragma unroll
        for (int q = 0; q < 8; ++q) { const float ya = y[q >> 1][q & 1], yb = y[4 + (q >> 1)][q & 1];
            const auto sw = __builtin_amdgcn_permlane16_swap(__float_as_uint(ya), __float_as_uint(yb), false, false); const unsigned s0 = sw[0], s1 = sw[1];
            z[q] = __uint_as_float(s0) + __uint_as_float(s1); }
#pragma unroll
        for (int q = 0; q < 4; ++q) { const auto sw = __builtin_amdgcn_permlane32_swap(__float_as_uint(z[q]), __float_as_uint(z[4 + q]), false, false); const unsigned s0 = sw[0], s1 = sw[1];
            zz[q] = __uint_as_float(s0) + __uint_as_float(s1); }
#pragma unroll
        for (int q = 0; q < 2; ++q) { const float kp = b0 ? zz[2 + q] : zz[q], sd = b0 ? zz[q] : zz[2 + q]; r[q] = kp + dpp_f<0x128>(sd); }
        const f32x2 hn = {bflo(hold) + r[0], bfhi(hold) + r[1]};
        const float ss = wave_sum(hn[0] * hn[0] + hn[1] * hn[1]);
        if (t < T) {
            *(unsigned*)(ws + (hbo + (unsigned)(t * 1024 + dd) * 2u)) = pk_bf16(hn[0], hn[1]);
            if (lane == 0) { *(float*)(ws + (sqo + (unsigned)(t * 16 + x) * 4u)) = ss; *(float*)(ws + (sqo + (unsigned)(t * 16 + 8 + x) * 4u)) = 0.f; }
        }
    };
    auto compute_roll = [&](int bufc, int hf, int bufn, u32x4 (&ln)[8], f32x2 (&y)[8]) {
        const float* wf = (const float*)(wbase + bufc * 256 + 128 + 64 * hf);
        const int* wn = wbase + bufn * 256 + 64 * hf;
#pragma unroll
        for (int m = 0; m < 8; ++m) {
            const float wk = wf[8 * m + g]; const f32x2 wk2 = {wk, wk};
            u32x4 lw = ln[m];
            asm volatile("" : "+v"(lw) : "v"(y[0]), "v"(y[7]));
            { const unsigned off = (unsigned)wn[8 * m + g] * 128u + voff; ln[m] = *(const u32x4*)(ws + off); }
#pragma unroll
            for (int i = 0; i < 4; ++i) {
                const f32x2 lo = __builtin_amdgcn_cvt_pk_f32_fp8((int)lw[i], false), hi = __builtin_amdgcn_cvt_pk_f32_fp8((int)lw[i], true);
                y[2 * i] = __builtin_elementwise_fma(wk2, lo, y[2 * i]); y[2 * i + 1] = __builtin_elementwise_fma(wk2, hi, y[2 * i + 1]);
            }
        }
    };
    G2Meta mA, mB; u32x4 H0[8], H1[8]; unsigned hoA, hoB; f32x2 y[8];
    load_meta(t0, mA); write_lds(mA, 0); hoA = mA.hold; issue(0, 0, H0); issue(0, 1, H1);
    load_meta(t0 + ts, mB); write_lds(mB, 1); hoB = mB.hold;
    for (int ta = t0; ta < T; ta += 2 * ts) {
        const int tb = ta + ts;
        load_meta(ta + 2 * ts, mA);
#pragma unroll
        for (int q = 0; q < 8; ++q) y[q] = (f32x2){0.f, 0.f};
        __builtin_amdgcn_sched_barrier(0);
        compute_roll(0, 0, 1, H0, y);
        __builtin_amdgcn_sched_barrier(0);
        compute_roll(0, 1, 1, H1, y);
        __builtin_amdgcn_sched_barrier(0);
        finish(ta, y, hoA);
        write_lds(mA, 0); hoA = mA.hold;
        load_meta(tb + 2 * ts, mB);
#pragma unroll
        for (int q = 0; q < 8; ++q) y[q] = (f32x2){0.f, 0.f};
        __builtin_amdgcn_sched_barrier(0);
        compute_roll(1, 0, 0, H0, y);
        __builtin_amdgcn_sched_barrier(0);
        compute_roll(1, 1, 0, H1, y);
        __builtin_amdgcn_sched_barrier(0);
        finish(tb, y, hoB);
        write_lds(mB, 1); hoB = mB.hold;
    }
}

__device__ __forceinline__ void final_phase(const int wv, const Params& p) {
    asm volatile("; ==== PHASE final");
    const int tid = opaque_tid(wv), wid = __builtin_amdgcn_readfirstlane(tid >> 6), lane = tid & 63;
    f32x4 gf[4];
#pragma unroll
    for (int i = 0; i < 4; ++i) gf[i] = *(const f32x4*)(p.g_final + 256 * i + 4 * lane);
    for (long t0 = (long)blockIdx.x * 8 + wid; t0 < T; t0 += (long)gridDim.x * 16) {
        const long t1 = t0 + (long)gridDim.x * 8; const bool two = t1 < T; const long t1c = two ? t1 : t0;
        u32x2 h0[4], h1[4];
#pragma unroll
        for (int i = 0; i < 4; ++i) { h0[i] = *(const u32x2*)(p.hb() + t0 * 1024 + 256 * i + 4 * lane); h1[i] = *(const u32x2*)(p.hb() + t1c * 1024 + 256 * i + 4 * lane); }
        const float rs0 = row_rstd(p.ssq(), t0), rs1 = row_rstd(p.ssq(), t1c);
        float* d0 = t0 < TP ? p.out + O_YP + t0 * 1024 : p.out + O_YS + (t0 - TP) * 1024;
        float* d1 = t1c < TP ? p.out + O_YP + t1c * 1024 : p.out + O_YS + (t1c - TP) * 1024;
#pragma unroll
        for (int i = 0; i < 4; ++i) __builtin_nontemporal_store((f32x4){bflo(h0[i].x), bfhi(h0[i].x), bflo(h0[i].y), bfhi(h0[i].y)} * gf[i] * rs0, (f32x4*)(d0 + 256 * i + 4 * lane));
        if (two) {
#pragma unroll
            for (int i = 0; i < 4; ++i) __builtin_nontemporal_store((f32x4){bflo(h1[i].x), bfhi(h1[i].x), bflo(h1[i].y), bfhi(h1[i].y)} * gf[i] * rs1, (f32x4*)(d1 + 256 * i + 4 * lane));
        }
    }
}

#define XB_TMO      128
#define XB_XCNT(j)  (256  + 64 * (j))
#define XB_XSUB(j)  (1280 + 64 * (j))
#define XB_XGEN(j)  (2304 + 64 * (j))
#define XB_TOP      3328
#define XB_TOPGEN   3392
#define XCD_BAR_WORDS 3456
#define XB_SPIN_CAP (1u << 22)
__device__ __forceinline__ unsigned xb_ld(unsigned* p)              { return __hip_atomic_load(p, __ATOMIC_RELAXED, __HIP_MEMORY_SCOPE_AGENT); }
__device__ __forceinline__ unsigned xb_add(unsigned* p, unsigned v) { return __hip_atomic_fetch_add(p, v, __ATOMIC_RELAXED, __HIP_MEMORY_SCOPE_AGENT); }
__device__ __forceinline__ unsigned xb_xcc_id() { return (unsigned)__builtin_amdgcn_s_getreg((3 << 11) | 20) & 0xFu; }
#define XB_SPIN(cond, bar) do { unsigned _sp = 0; while (cond) { __builtin_amdgcn_s_sleep(1); \
    if ((++_sp & 255u) == 0u) { if (xb_ld(&(bar)[XB_TMO])) break; if (_sp > XB_SPIN_CAP) { atomicAdd(&(bar)[XB_TMO], 1u); break; } } } } while (0)
struct XcdBarrier { unsigned* bar; unsigned x, nloc, nx; };
__device__ __forceinline__ unsigned xcd_barrier_post(XcdBarrier& b, unsigned* bar) {
    b.bar = bar; b.x = xb_xcc_id(); b.nloc = 0u; b.nx = 0u;
    unsigned rank = 0u;
    if (threadIdx.x == 0) rank = xb_add(&bar[XB_XCNT(b.x)], 1u);
    return rank;
}
__device__ __forceinline__ void xcd_barrier_complete(unsigned* bar, unsigned x, unsigned& nloc, unsigned& nx) {
    const unsigned G = gridDim.x;
    unsigned sum, cnt, mine, sp = 0u;
    for (;;) {
        sum = 0u; cnt = 0u; mine = 0u;
#pragma unroll
        for (unsigned j = 0; j < 16; ++j) { const unsigned c = xb_ld(&bar[XB_XCNT(j)]); sum += c; cnt += (c > 0u) ? 1u : 0u; mine = (j == x) ? c : mine; }
        if (sum == G) break;
        __builtin_amdgcn_s_sleep(1);
        if ((++sp & 255u) == 0u) { if (xb_ld(&bar[XB_TMO])) break; if (sp > XB_SPIN_CAP) { atomicAdd(&bar[XB_TMO], 1u); break; } }
    }
    nloc = mine > 0u ? mine : 1u; nx = cnt > 0u ? cnt : 1u;
}
__device__ __forceinline__ void xcd_barrier(XcdBarrier& b, const int wv) {
    const bool t0 = wv == 0 && lane_id() == 0;
    asm volatile("s_waitcnt vmcnt(0)" ::: "memory");
    __syncthreads();
    if (b.nloc == 0u) {
        unsigned nl = 0u, nxx = 0u;
        if (t0) xcd_barrier_complete(b.bar, b.x, nl, nxx);
        b.nloc = __builtin_amdgcn_readfirstlane(nl); b.nx = __builtin_amdgcn_readfirstlane(nxx);
    }
    if (t0) {
        unsigned* bar = b.bar;
        __builtin_amdgcn_s_waitcnt(0);
        const unsigned nloc = b.nloc, nx = b.nx;
        const unsigned old = xb_add(&bar[XB_XSUB(b.x)], 1u);
        const unsigned gen = old / nloc;
        if (old + 1u == (gen + 1u) * nloc) {
            __builtin_amdgcn_fence(__ATOMIC_RELEASE, "agent");
            asm volatile("s_waitcnt vmcnt(0)" ::: "memory");
            const unsigned og = xb_add(&bar[XB_TOP], 1u);
            const unsigned tg = og / nx;
            if (og + 1u == (tg + 1u) * nx) xb_add(&bar[XB_TOPGEN], 1u);
            else XB_SPIN(xb_ld(&bar[XB_TOPGEN]) == tg, bar);
            __builtin_amdgcn_fence(__ATOMIC_ACQUIRE, "agent");
            xb_add(&bar[XB_XGEN(b.x)], 1u);
            asm volatile("s_waitcnt vmcnt(0)" ::: "memory");
        } else {
            XB_SPIN(xb_ld(&bar[XB_XGEN(b.x)]) == gen, bar);
            __builtin_amdgcn_fence(__ATOMIC_ACQUIRE, "agent");
            asm volatile("s_waitcnt vmcnt(0)" ::: "memory");
        }
    }
    __syncthreads();
}

__global__ void __launch_bounds__(NTHREADS) mega(Params p_arg) {
    __shared__ __attribute__((aligned(16))) unsigned char lds[LDS_BYTES];
    cg::grid_group grid = cg::this_grid();
    const int wv = __builtin_amdgcn_readfirstlane((int)threadIdx.x >> 6);
    XcdBarrier xb; const unsigned rank0 = xcd_barrier_post(xb, p_arg.bar());
    if (threadIdx.x == 0) *(volatile unsigned*)lds = rank0;
    __syncthreads();
    const int myrank = __builtin_amdgcn_readfirstlane((int)*(volatile unsigned*)lds);
    __syncthreads();
    int gx = (int)(blockIdx.x & 7), gt = (int)(blockIdx.x >> 3);
    const int phase_lo = p_arg.phase_lo, phase_hi = p_arg.phase_hi;
    if (phase_lo > 1000000) grid.sync();
    for (int ph = phase_lo; ph < phase_hi; ++ph) {
        if (ph == phase_lo + 1) {
            xcd_barrier(xb, wv);
            bool regular = (gridDim.x & 7) == 0;
#pragma unroll
            for (unsigned jx = 0; jx < 16; ++jx) { const unsigned c = xb_ld(&p_arg.bar()[XB_XCNT(jx)]); regular = regular && (c == (jx < 8 ? gridDim.x >> 3 : 0u)); }
            if (regular) { gx = (int)xb.x; gt = myrank; }
        } else if (ph > phase_lo) xcd_barrier(xb, wv);
        const Params& p = p_arg;
        const int layer = (ph - 1) / 7, sub = ph == 0 ? 7 : ph == NPHASES - 1 ? 8 : (ph - 1) % 7, j = layer >> 1;
        const bool isconv = layer & 1;
        const int reps = ((DUPMASK >> sub) & 1) ? 2 : 1;
        for (int rep = 0; rep < reps; ++rep) {
            if (rep) xcd_barrier(xb, wv);
            if (sub == 7) prep_phase(wv, p, lds);
            else if (sub == 8) final_phase(wv, p);
            else if (sub == 0) {
                if (!isconv) gemm_phase(wv, p.hb(), p.wqkv_t() + (long)j * 1536 * 1024, 6, EpiQKV{p, j}, lds, gx, gt);
                else gemm_phase(wv, p.hb(), p.win_t() + (long)j * 3072 * 1024, 12, EpiWin{p, j}, lds, gx, gt);
            } else if (sub == 1) {
                if (!isconv) attn_phase(wv, p, j, lds); else convz_phase(wv, p, j);
            } else if (sub == 2) {
                const bool dry = (DUPMASK & 4) && rep == 0;
                EpiRes er{p.hb(), dry ? (bf16_t*)(p.dmy() + (long)T * 1024) : p.hb(), dry ? p.dmy() + (long)T * 1536 : p.ssq()};
                gemm_phase(wv, p.o(), (isconv ? p.wout_t() : p.wo_t()) + (long)j * 1024 * 1024, 4, er, lds, gx, gt);
            } else if (sub == 3) peerq_phase(wv, p, layer, lds, gx, gt);
            else if (sub == 4) g1_phase(wv, p, layer, lds, gx, gt);
            else if (sub == 5) g15_phase(wv, p, layer, ((DUPMASK & 32) && rep == 0) ? p.dmy() + (long)T * 1552 : p.sel_g());
            else g2_phase(wv, p, layer, lds, (DUPMASK & 64) && rep == 0, gx, gt);
        }
    }
}

extern "C" void kernel_launch(void* const* d_in, const int* in_sizes, int n_in, void* d_out, int out_size, void* d_ws, size_t ws_size, hipStream_t stream) {
    Params p{};
    const float* const* in = (const float* const*)d_in;
    p.x_prompt = in[0]; p.x_sample = in[1]; p.cache_k = in[2]; p.cache_v = in[3]; p.state_conv = in[4]; p.g_mix = in[5]; p.g_ffn = in[6]; p.g_final = in[7]; p.rel_bias = in[8];
    p.w_qkv = in[9]; p.sinks = in[10]; p.w_o = in[11]; p.w_in = in[12]; p.conv_w = in[13]; p.w_out = in[14]; p.w_q = in[15]; p.sub_keys = in[16]; p.peer_u = in[17]; p.peer_v = in[18];
    p.out = (float*)d_out;
    p.ws = (unsigned char*)d_ws;
    if (ws_size < WS_END) fprintf(stderr, "workspace too small: %zu < %zu\n", ws_size, (size_t)WS_END);
    static int grid_blocks = 0;
    if (!grid_blocks) {
        int dev = 0, cus = 0, per_cu = 0;
        hipGetDevice(&dev);
        hipDeviceGetAttribute(&cus, hipDeviceAttributeMultiprocessorCount, dev);
        hipOccupancyMaxActiveBlocksPerMultiprocessor(&per_cu, mega, NTHREADS, 0);
        if (per_cu > 1) per_cu = 1;
        grid_blocks = cus * per_cu;
        if (grid_blocks <= 0) grid_blocks = 256;
    }
    hipMemsetAsync(p.ws + WS_BAR, 0, XCD_BAR_WORDS * 4, stream);
#if ONE_LAUNCH
    p.phase_lo = 0; p.phase_hi = NPHASES;
    void* args[] = {&p};
    hipError_t e = hipLaunchCooperativeKernel((void*)mega, dim3(grid_blocks), dim3(NTHREADS), args, 0, stream);
    if (e != hipSuccess) fprintf(stderr, "cooperative launch failed: %s (grid %d)\n", hipGetErrorString(e), grid_blocks);
#else
    for (int ph = 0; ph < NPHASES; ++ph) {
        p.phase_lo = ph; p.phase_hi = ph + 1;
        hipLaunchKernelGGL(mega, dim3(grid_blocks), dim3(NTHREADS), 0, stream, p);
    }
#endif
}
```

```cpp
#include <hip/hip_runtime.h>
#include <hip/hip_cooperative_groups.h>
#include <cstdio>
namespace cg = cooperative_groups;

typedef unsigned short bf16_t;
typedef short bf16x8 __attribute__((ext_vector_type(8)));
typedef float f32x4 __attribute__((ext_vector_type(4)));
typedef float f32x2 __attribute__((ext_vector_type(2)));
typedef unsigned u32x4 __attribute__((ext_vector_type(4)));
typedef unsigned u32x2 __attribute__((ext_vector_type(2)));
typedef int i32x8 __attribute__((ext_vector_type(8)));
typedef int i32x2 __attribute__((ext_vector_type(2)));

#ifndef XPROBE
#define XPROBE 0
#endif
#ifndef DUPMASK
#define DUPMASK 0
#endif
#ifndef ONE_LAUNCH
#define ONE_LAUNCH 1
#define CVT_QKV_UNITS 512
#endif

constexpr int TP = 16384, TS = 512, T = TP + TS;
constexpr int NTHREADS = 512;
constexpr int LDS_BYTES = 163840;
constexpr int NPHASES = 30;
constexpr float EPS = 1e-6f;
constexpr long O_YP = 0, O_YS = 16777216, O_KP = 17301504, O_VP = 17563648, O_CP = 17825792, O_KS = 17842176, O_VS = 26230784, O_CS = 34619392;

constexpr size_t al256(size_t x) { return (x + 255) & ~(size_t)255; }
constexpr size_t WS_H = 0;
constexpr size_t WS_HB = WS_H + al256((size_t)T * 1024 * 4);
constexpr size_t WS_SSQ = WS_HB + al256((size_t)T * 1024 * 2);
constexpr size_t WS_Q = WS_SSQ + al256((size_t)T * 16 * 4);
constexpr size_t WS_K = WS_Q + al256((size_t)T * 1024 * 2);
constexpr size_t WS_V = WS_K + al256((size_t)T * 256 * 2);
constexpr size_t WS_O = WS_V + al256((size_t)T * 256 * 2);
constexpr size_t WS_BG = WS_O + al256((size_t)T * 1024 * 2);
constexpr size_t WS_UB = WS_BG + al256((size_t)T * 1024 * 2);
constexpr size_t WS_SELI = WS_UB + al256((size_t)T * 1024 * 2);
constexpr size_t WS_SELG = WS_SELI + al256((size_t)T * 128 * 4);
constexpr size_t WS_SELSU = WS_SELG + al256((size_t)T * 128 * 4);
constexpr size_t WS_WQKV = WS_SELSU + al256((size_t)T * 128 * 4);
constexpr size_t WS_WO = WS_WQKV + al256((size_t)2 * 1536 * 1024 * 2);
constexpr size_t WS_WIN = WS_WO + al256((size_t)2 * 1024 * 1024 * 2);
constexpr size_t WS_WOUT = WS_WIN + al256((size_t)2 * 3072 * 1024 * 2);
constexpr size_t WS_WQ = WS_WOUT + al256((size_t)2 * 1024 * 1024 * 2);
constexpr size_t WS_SUBK = WS_WQ + al256((size_t)4 * 2048 * 1024 * 2);
constexpr size_t WS_PART = WS_SUBK + al256((size_t)4 * 8 * 2 * 128 * 128 * 2);
constexpr size_t WS_BAR = WS_PART + al256((size_t)T * 8 * 128 * 4);
constexpr size_t WS_DMY = WS_BAR + al256(16384);
constexpr size_t WS_U8 = WS_DMY + al256((size_t)T * 1024 * 4 + (size_t)T * 1024 * 2 + (size_t)T * 16 * 4 + (size_t)T * 128 * 4 + 4096);
constexpr size_t WS_V8 = WS_U8 + al256((size_t)4 * 16384 * 1024);
constexpr size_t WS_SU = WS_V8 + al256((size_t)4 * 16384 * 1024);
constexpr size_t WS_SV = WS_SU + al256((size_t)4 * 16384 * 4);
constexpr size_t WS_END = WS_SV + al256((size_t)4 * 16384 * 4);

struct Params {
    const float *x_prompt, *x_sample, *cache_k, *cache_v, *state_conv, *g_mix, *g_ffn, *g_final, *rel_bias, *w_qkv, *sinks, *w_o, *w_in, *conv_w, *w_out, *w_q, *sub_keys, *peer_u, *peer_v;
    float* out;
    unsigned char* ws;
    int phase_lo, phase_hi;
    __device__ __forceinline__ float* h() const { return (float*)(ws + WS_H); }
    __device__ __forceinline__ bf16_t* hb() const { return (bf16_t*)(ws + WS_HB); }
    __device__ __forceinline__ float* ssq() const { return (float*)(ws + WS_SSQ); }
    __device__ __forceinline__ bf16_t* q() const { return (bf16_t*)(ws + WS_Q); }
    __device__ __forceinline__ bf16_t* k() const { return (bf16_t*)(ws + WS_K); }
    __device__ __forceinline__ bf16_t* v() const { return (bf16_t*)(ws + WS_V); }
    __device__ __forceinline__ bf16_t* o() const { return (bf16_t*)(ws + WS_O); }
    __device__ __forceinline__ bf16_t* bg() const { return (bf16_t*)(ws + WS_BG); }
    __device__ __forceinline__ bf16_t* ub() const { return (bf16_t*)(ws + WS_UB); }
    __device__ __forceinline__ int* sel_idx() const { return (int*)(ws + WS_SELI); }
    __device__ __forceinline__ float* sel_g() const { return (float*)(ws + WS_SELG); }
    __device__ __forceinline__ float* sel_su() const { return (float*)(ws + WS_SELSU); }
    __device__ __forceinline__ bf16_t* wqkv_t() const { return (bf16_t*)(ws + WS_WQKV); }
    __device__ __forceinline__ bf16_t* wo_t() const { return (bf16_t*)(ws + WS_WO); }
    __device__ __forceinline__ bf16_t* win_t() const { return (bf16_t*)(ws + WS_WIN); }
    __device__ __forceinline__ bf16_t* wout_t() const { return (bf16_t*)(ws + WS_WOUT); }
    __device__ __forceinline__ bf16_t* wq_t() const { return (bf16_t*)(ws + WS_WQ); }
    __device__ __forceinline__ bf16_t* subk() const { return (bf16_t*)(ws + WS_SUBK); }
    __device__ __forceinline__ float* part() const { return (float*)(ws + WS_PART); }
    __device__ __forceinline__ unsigned* bar() const { return (unsigned*)(ws + WS_BAR); }
    __device__ __forceinline__ float* dmy() const { return (float*)(ws + WS_DMY); }
    __device__ __forceinline__ unsigned char* u8() const { return ws + WS_U8; }
    __device__ __forceinline__ unsigned char* v8() const { return ws + WS_V8; }
    __device__ __forceinline__ float* su() const { return (float*)(ws + WS_SU); }
    __device__ __forceinline__ float* sv() const { return (float*)(ws + WS_SV); }
};

__device__ const unsigned char kBucket[128] = {0,1,2,3,4,5,6,7,8,9,10,11,12,13,14,15,16,16,16,17,17,18,18,18,19,19,19,20,20,20,20,21,21,21,21,22,22,22,22,22,23,23,23,23,23,23,24,24,24,24,24,24,25,25,25,25,25,25,25,26,26,26,26,26,26,26,26,27,27,27,27,27,27,27,27,27,27,28,28,28,28,28,28,28,28,28,28,29,29,29,29,29,29,29,29,29,29,29,29,30,30,30,30,30,30,30,30,30,30,30,30,30,30,31,31,31,31,31,31,31,31,31,31,31,31,31,31,31};

__device__ __forceinline__ unsigned pk_bf16(float lo, float hi) { unsigned r; asm("v_cvt_pk_bf16_f32 %0, %1, %2" : "=v"(r) : "v"(lo), "v"(hi)); return r; }
__device__ __forceinline__ bf16_t f2bf(float x) { return (bf16_t)(pk_bf16(x, 0.f) & 0xffffu); }
__device__ __forceinline__ float bf2f(unsigned b) { return __uint_as_float(b << 16); }
__device__ __forceinline__ float bflo(unsigned w) { return __uint_as_float(w << 16); }
__device__ __forceinline__ float bfhi(unsigned w) { return __uint_as_float(w & 0xffff0000u); }
__device__ __forceinline__ void wg_barrier() { asm volatile("" ::: "memory"); __builtin_amdgcn_s_barrier(); asm volatile("" ::: "memory"); }
__device__ __forceinline__ void lds_barrier() { asm volatile("s_waitcnt lgkmcnt(0)" ::: "memory"); __builtin_amdgcn_s_barrier(); asm volatile("" ::: "memory"); }
__device__ __forceinline__ void full_barrier() { asm volatile("s_waitcnt vmcnt(0) lgkmcnt(0)" ::: "memory"); __builtin_amdgcn_s_barrier(); asm volatile("" ::: "memory"); }

__device__ __forceinline__ int lane_id() { int l; asm volatile("v_mbcnt_lo_u32_b32 %0, -1, 0\n\tv_mbcnt_hi_u32_b32 %0, -1, %0" : "=v"(l)); return l; }
__device__ __forceinline__ int opaque_tid(int wv) { int t = (wv << 6) | lane_id(); asm volatile("" : "+v"(t)); return t; }
template <int CTRL> __device__ __forceinline__ float dpp_f(float v) { return __int_as_float(__builtin_amdgcn_update_dpp(0, __float_as_int(v), CTRL, 0xf, 0xf, true)); }
__device__ __forceinline__ float row16_sum(float v) {
    v += dpp_f<0xB1>(v);
    v += dpp_f<0x4E>(v);
    v += dpp_f<0x141>(v);
    v += dpp_f<0x140>(v);
    return v;
}
__device__ __forceinline__ float wave_sum(float v) {
    v = row16_sum(v);
    v += __shfl_xor(v, 16); v += __shfl_xor(v, 32);
    return v;
}

__device__ __forceinline__ int lds_byte(int r, int c) { int st = (r >> 4) * 2 + (c >> 5), rr = r & 15, cc = c & 31, ob = rr * 64 + cc * 2; return st * 1024 + (ob ^ (((ob >> 9) & 1) << 5)); }
__device__ __forceinline__ void stage_rc(int b, int& R, int& C) { int st = b / 1024, sb = b % 1024, swz = sb ^ (((sb >> 9) & 1) << 5); R = (st >> 1) * 16 + swz / 64; C = (st & 1) * 32 + (swz % 64) / 2; }

__device__ __forceinline__ int perm32(int rho) { const int n = rho >> 4, i = rho & 15; return 8 * (i >> 2) + 4 * n + (i & 3); }
__device__ __forceinline__ void stage_half(const bf16_t* G, long row0, int ld, int col0, unsigned char* dst, int tid) {
#pragma unroll
    for (int i = 0; i < 2; ++i) {
        int b = tid * 16 + i * 8192; int R, C; stage_rc(b, R, C);
        __builtin_amdgcn_global_load_lds((const unsigned*)(G + (row0 + R) * ld + col0 + C), (unsigned*)(dst + b), 16, 0, 0);
    }
}

__device__ __forceinline__ void stage_offsets(int tid, int ld, unsigned (&voff)[2]) {
#pragma unroll
    for (int i = 0; i < 2; ++i) { int b = tid * 16 + i * 8192; int R, C; stage_rc(b, R, C); voff[i] = (unsigned)(R * ld + C) * 2u; }
}
__device__ __forceinline__ void stage_half_u(const bf16_t* ubase, const unsigned (&voff)[2], unsigned char* dst, int tid) {
#pragma unroll
    for (int i = 0; i < 2; ++i)
        __builtin_amdgcn_global_load_lds((const unsigned*)((const unsigned char*)ubase + voff[i]), (unsigned*)(dst + tid * 16 + i * 8192), 16, 0, 0);
}

__device__ __forceinline__ f32x4 mfma16(bf16x8 a, bf16x8 b, f32x4 c) { return __builtin_amdgcn_mfma_f32_16x16x32_bf16(a, b, c, 0, 0, 0); }

__device__ __forceinline__ float row_rstd(const float* ssq, long row) {
    const f32x4* p = (const f32x4*)(ssq + (unsigned)(row * 16));
    f32x4 a = p[0], b = p[1], c = p[2], d = p[3];
    float s = ((a[0] + a[1]) + (a[2] + a[3])) + ((b[0] + b[1]) + (b[2] + b[3])) + ((c[0] + c[1]) + (c[2] + c[3])) + ((d[0] + d[1]) + (d[2] + d[3]));
    return rsqrtf(s * (1.0f / 1024.0f) + EPS);
}
__device__ __forceinline__ f32x4 row_ssq_q(const float* ssq, long row, int fq) { return *(const f32x4*)(ssq + (unsigned)(row * 16 + 4 * fq)); }
__device__ __forceinline__ float row_rstd_q(const f32x4 a) {
    float s = (a[0] + a[1]) + (a[2] + a[3]);
    { const auto sw = __builtin_amdgcn_permlane16_swap(__float_as_uint(s), __float_as_uint(s), false, false); const unsigned s0 = sw[0], s1 = sw[1]; s = __uint_as_float(s0) + __uint_as_float(s1); }
    { const auto sw = __builtin_amdgcn_permlane32_swap(__float_as_uint(s), __float_as_uint(s), false, false); const unsigned s0 = sw[0], s1 = sw[1]; s = __uint_as_float(s0) + __uint_as_float(s1); }
    return rsqrtf(s * (1.0f / 1024.0f) + EPS);
}

template <int NBH> struct GemmCfg;
template <> struct GemmCfg<1> { static constexpr int MR = 2, NR = 4; };
template <> struct GemmCfg<2> { static constexpr int MR = 4, NR = 4; };

template <int NBH>
__device__ __forceinline__ void gemm_kloop(const int tid, const bf16_t* A, long arow0, const bf16_t* Bt, long brow0, unsigned char* lds, f32x4 (&acc)[GemmCfg<NBH>::MR][GemmCfg<NBH>::NR]) {
    constexpr int MR = GemmCfg<NBH>::MR, NR = GemmCfg<NBH>::NR;
    constexpr int SS = (1 + NBH) * 16384, NS = NBH == 1 ? 4 : 3, NL = 2 * (1 + NBH);
    const int wid = tid >> 6, lane = tid & 63, fr = lane & 15, fq = lane >> 4;
    int arow, bhalf, brow;
    if (NBH == 1) { arow = 32 * (wid >> 1); bhalf = 0; brow = 64 * (wid & 1); }
    else { arow = 64 * (wid >> 2); bhalf = (wid & 3) >> 1; brow = 64 * (wid & 1); }
#pragma unroll
    for (int m = 0; m < MR; ++m)
#pragma unroll
        for (int n = 0; n < NR; ++n) acc[m][n] = (f32x4){0.f, 0.f, 0.f, 0.f};
    unsigned voff[2]; stage_offsets(tid, 1024, voff);
    auto issue = [&](int kt) {
        unsigned char* base = lds + (kt % NS) * SS;
        stage_half_u(A + (arow0 * 1024 + kt * 64), voff, base, tid);
#pragma unroll
        for (int hb = 0; hb < NBH; ++hb) stage_half_u(Bt + ((brow0 + 128 * hb) * 1024 + kt * 64), voff, base + 16384 * (1 + hb), tid);
    };
#pragma unroll
    for (int kt = 0; kt < NS - 1; ++kt) issue(kt);
#pragma unroll
    for (int t = 0; t < 16; ++t) {
        constexpr int dummy = 0; (void)dummy;
        const int younger = (15 - t) < (NS - 2) ? (15 - t) : (NS - 2);
        if (younger * NL == 12) asm volatile("s_waitcnt vmcnt(12)" ::: "memory");
        else if (younger * NL == 8) asm volatile("s_waitcnt vmcnt(8)" ::: "memory");
        else if (younger * NL == 6) asm volatile("s_waitcnt vmcnt(6)" ::: "memory");
        else if (younger * NL == 4) asm volatile("s_waitcnt vmcnt(4)" ::: "memory");
        else asm volatile("s_waitcnt vmcnt(0)" ::: "memory");
        wg_barrier();
        if (t + NS - 1 < 16) issue(t + NS - 1);
        const unsigned char* Ab = lds + (t % NS) * SS;
        const unsigned char* Bb = Ab + 16384 * (1 + bhalf);
#pragma unroll
        for (int k = 0; k < 2; ++k) {
            bf16x8 a[MR], b[NR];
#pragma unroll
            for (int m = 0; m < MR; ++m) a[m] = *(const bf16x8*)(Ab + lds_byte(arow + 16 * m + fr, 32 * k + 8 * fq));
#pragma unroll
            for (int n = 0; n < NR; ++n) b[n] = *(const bf16x8*)(Bb + lds_byte(brow + 16 * n + fr, 32 * k + 8 * fq));
#pragma unroll
            for (int m = 0; m < MR; ++m)
#pragma unroll
                for (int n = 0; n < NR; ++n) acc[m][n] = mfma16(b[n], a[m], acc[m][n]);
        }
    }
    lds_barrier();
}

struct TileDesc { const float* W; int ldw, k0, n0; bf16_t* out; const float* gs; float hasg; int mode; };
__device__ __forceinline__ TileDesc tile_desc(const Params& p, int u) {
    TileDesc d; int v = u;
    if (v < 768) { int l = v / 384, r = v % 384; d = TileDesc{p.w_qkv + (long)l * 1024 * 1536, 1536, (r / 24) * 64, (r % 24) * 64, p.wqkv_t() + (long)l * 1536 * 1024, p.g_mix + (2 * l) * 1024, 1.f, 0}; return d; }
    v -= 768;
    if (v < 512) { int l = v / 256, r = v % 256; d = TileDesc{p.w_o + (long)l * 1024 * 1024, 1024, (r / 16) * 64, (r % 16) * 64, p.wo_t() + (long)l * 1024 * 1024, p.g_mix, 0.f, 0}; return d; }
    v -= 512;
    if (v < 1536) { int l = v / 768, r = v % 768; d = TileDesc{p.w_in + (long)l * 1024 * 3072, 3072, (r / 48) * 64, (r % 48) * 64, p.win_t() + (long)l * 3072 * 1024, p.g_mix + (2 * l + 1) * 1024, 1.f, 1}; return d; }
    v -= 1536;
    if (v < 512) { int l = v / 256, r = v % 256; d = TileDesc{p.w_out + (long)l * 1024 * 1024, 1024, (r / 16) * 64, (r % 16) * 64, p.wout_t() + (long)l * 1024 * 1024, p.g_mix, 0.f, 0}; return d; }
    v -= 512;
    { int l = v / 512, r = v % 512; d = TileDesc{p.w_q + (long)l * 1024 * 2048, 2048, (r / 32) * 64, (r % 32) * 64, p.wq_t() + (long)l * 2048 * 1024, p.g_ffn + l * 1024, 1.f, 0}; return d; }
}
__device__ __forceinline__ void tile_load(const int tid, const TileDesc& d, f32x4 (&x)[4]) {
#pragma unroll
    for (int i = 0; i < 2; ++i) { const int idx = tid + 512 * i, k = idx >> 4, n4 = idx & 15; x[i] = __builtin_nontemporal_load((const f32x4*)(d.W + (long)(d.k0 + k) * d.ldw + d.n0 + n4 * 4)); }
    const int kq = tid >> 6;
    x[2] = *(const f32x4*)(d.gs + d.k0 + 8 * kq); x[3] = *(const f32x4*)(d.gs + d.k0 + 8 * kq + 4);
}
__device__ __forceinline__ void tile_finish(const int tid, const TileDesc& d, const f32x4 (&x)[4], float* tile) {
#pragma unroll
    for (int i = 0; i < 2; ++i) { const int idx = tid + 512 * i, k = idx >> 4, n4 = idx & 15; *(f32x4*)(tile + k * 68 + n4 * 4) = x[i]; }
    __syncthreads();
    const int nl = tid & 63, kq = tid >> 6;
    const f32x4 g0 = x[2], g1 = x[3];
    float v[8];
#pragma unroll
    for (int i = 0; i < 8; ++i) { const float g = (i < 4 ? g0[i] : g1[i - 4]) * d.hasg + (1.0f - d.hasg); v[i] = tile[(8 * kq + i) * 68 + nl] * g; }
    const int n = d.n0 + nl; int orow = n;
    if (d.mode == 1 && n >= 1024) { const int ch = (n - 1024) & 1023; const int isH = (n >= 2048); orow = 1024 + 8 * (ch >> 2) + 4 * isH + (ch & 3); }
    u32x4 w; w.x = pk_bf16(v[0], v[1]); w.y = pk_bf16(v[2], v[3]); w.z = pk_bf16(v[4], v[5]); w.w = pk_bf16(v[6], v[7]);
    *(u32x4*)(d.out + (long)orow * 1024 + d.k0 + 8 * kq) = w;
    __syncthreads();
}

__device__ __forceinline__ void convert_tables(const Params& p, const int wid, const int lane, const int layer, const int first, const int stride, const int lo, const int hi) {
    for (int u = lo + first; u < hi; u += stride) {
        f32x4 x[4][4];
#pragma unroll
        for (int q = 0; q < 4; ++q) {
            const int r = (u * 8 + wid) * 4 + q; const int tbl = r >> 14; const long rr = (long)layer * 16384 + (r & 16383);
            const float* src = (tbl ? p.peer_v : p.peer_u) + rr * 1024;
#pragma unroll
            for (int i = 0; i < 4; ++i) x[q][i] = __builtin_nontemporal_load((const f32x4*)(src + 256 * i + 4 * lane));
        }
#pragma unroll
        for (int q = 0; q < 4; ++q) {
            const int r = (u * 8 + wid) * 4 + q; const int tbl = r >> 14; const long rr = (long)layer * 16384 + (r & 16383);
            float am = 0.f;
#pragma unroll
            for (int i = 0; i < 4; ++i) am = fmaxf(am, fmaxf(fmaxf(fabsf(x[q][i][0]), fabsf(x[q][i][1])), fmaxf(fabsf(x[q][i][2]), fabsf(x[q][i][3]))));
#pragma unroll
            for (int o = 32; o >= 1; o >>= 1) am = fmaxf(am, __shfl_xor(am, o));
            const float inv = am > 0.f ? 416.0f / am : 0.f; const float sc = am > 0.f ? am / 416.0f : 1.0f;
            u32x4 w;
#pragma unroll
            for (int i = 0; i < 4; ++i) { int t0 = __builtin_amdgcn_cvt_pk_fp8_f32(x[q][i][0] * inv, x[q][i][1] * inv, 0, false); t0 = __builtin_amdgcn_cvt_pk_fp8_f32(x[q][i][2] * inv, x[q][i][3] * inv, t0, true); w[i] = (unsigned)t0; }
            *(u32x4*)((tbl ? p.v8() : p.u8()) + (((rr >> 14) * 8 + (lane >> 3)) * 16384 + (rr & 16383)) * 128 + 16 * (lane & 7)) = w;
            if (lane == 0) (tbl ? p.sv() : p.su())[rr] = sc;
        }
    }
}

__device__ __forceinline__ void prep_phase(const int wv, const Params& p, unsigned char* lds) {
    asm volatile("; ==== PHASE prep");
    const int tid = opaque_tid(wv), wid = tid >> 6, lane = tid & 63;
    const int G = gridDim.x; int B = blockIdx.x; asm volatile("" : "+s"(B));
    float* tile = (float*)lds;
    if (B < 5376) {
        auto clampu = [&](int u) { return u < 5376 ? u : B; };
        TileDesc da = tile_desc(p, B), db = tile_desc(p, clampu(B + G)), dc = da;
        f32x4 xa[4], xb[4], xc[4];
        tile_load(tid, da, xa); tile_load(tid, db, xb);
        for (int u = B; u < 5376; u += 3 * G) {
            dc = tile_desc(p, clampu(u + 2 * G)); tile_load(tid, dc, xc);
            tile_finish(tid, da, xa, tile);
            if (u + G >= 5376) break;
            da = tile_desc(p, clampu(u + 3 * G)); tile_load(tid, da, xa);
            tile_finish(tid, db, xb, tile);
            if (u + 2 * G >= 5376) break;
            db = tile_desc(p, clampu(u + 4 * G)); tile_load(tid, db, xb);
            tile_finish(tid, dc, xc, tile);
        }
    }
    for (int u = B; u < 256; u += G) {
        long e = (long)u * 4096 + tid * 8;
        f32x4 a = __builtin_nontemporal_load((const f32x4*)(p.sub_keys + e)), b = __builtin_nontemporal_load((const f32x4*)(p.sub_keys + e + 4));
        u32x4 w; w.x = pk_bf16(a[0], a[1]); w.y = pk_bf16(a[2], a[3]); w.z = pk_bf16(b[0], b[1]); w.w = pk_bf16(b[2], b[3]);
        *(u32x4*)(p.subk() + e) = w;
    }
    convert_tables(p, wid, lane, 0, B, G, ((G & 7) == 0 && (48 % (G >> 3)) != 0) ? CVT_QKV_UNITS : 0, 1024);
    for (int u = B; u < T / 32; u += G) {
        f32x4 x[4][4];
#pragma unroll
        for (int q = 0; q < 4; ++q) {
            const long t = (long)(u * 8 + wid) * 4 + q;
            const float* src = t < TP ? p.x_prompt + t * 1024 : p.x_sample + (t - TP) * 1024;
#pragma unroll
            for (int i = 0; i < 4; ++i) x[q][i] = __builtin_nontemporal_load((const f32x4*)(src + 256 * i + 4 * lane));
        }
#pragma unroll
        for (int q = 0; q < 4; ++q) {
            const long t = (long)(u * 8 + wid) * 4 + q;
            float ss = 0.f;
#pragma unroll
            for (int i = 0; i < 4; ++i) {
                const f32x4 xv = x[q][i];
                u32x2 w; w.x = pk_bf16(xv[0], xv[1]); w.y = pk_bf16(xv[2], xv[3]);
                *(u32x2*)(p.hb() + t * 1024 + 256 * i + 4 * lane) = w;
                ss += (xv[0] * xv[0] + xv[1] * xv[1]) + (xv[2] * xv[2] + xv[3] * xv[3]);
            }
            ss = wave_sum(ss);
            if (lane < 16) p.ssq()[t * 16 + lane] = lane == 0 ? ss : 0.f;
        }
    }
}

#define LAS __attribute__((address_space(3)))
template <class Epi>
__device__ __forceinline__ void gemm256_units(const int tid, LAS unsigned char* lds, const bf16_t* A, const bf16_t* Bt, const int nN, const int u0, const int G, const int nunits, const Epi& E) {
    constexpr int K = 1024, BK = 64, HALF = 128, HTB = HALF * BK * 2, nt = K / BK;
    const int wid = __builtin_amdgcn_readfirstlane(tid >> 6), lane = tid & 63, wr = wid >> 2, wc = wid & 3, fr = lane & 15, fq = lane >> 4;
    int u = u0;
    if (u >= nunits) return;
    unsigned voff[2], voffB[2];
#pragma unroll
    for (int i = 0; i < 2; ++i) { int R, C; stage_rc(tid * 16 + i * 8192, R, C); const int Rb = Epi::PERM ? ((R & ~31) + perm32(R & 31)) : R;
        voff[i] = (unsigned)(R * K + C) * 2u; voffB[i] = (unsigned)(Rb * K + C) * 2u; }
    const size_t kstep = (size_t)(BK * 2), hstep = (size_t)HALF * K * 2, tstep = 2 * hstep;
    const unsigned ldsw = (unsigned)wid * 1024u;
    const int aoff = lds_byte(wr * 64 + fr, fq * 8), boff = lds_byte(wc * 32 + fr, fq * 8);
#define PG8_SA(b, h) (((b) * 2 + (h)) * HTB)
#define PG8_SB(b, h) ((4 + (b) * 2 + (h)) * HTB)
#define PG8_STAGE_V(bufoff, gbase, vo) do { _Pragma("unroll") for (int _i = 0; _i < 2; ++_i) \
        __builtin_amdgcn_global_load_lds((const unsigned*)((const char*)(gbase) + (vo)[_i]), (LAS unsigned*)(lds + (bufoff) + ldsw + _i * 8192), 16, 0, 0); } while (0)
#define PG8_STAGE(bufoff, gbase) PG8_STAGE_V(bufoff, gbase, voff)
#define PG8_STAGEB(bufoff, gbase) PG8_STAGE_V(bufoff, gbase, voffB)
#define PG8_LDA(dst, b, h) do { _Pragma("unroll") for (int m = 0; m < 4; ++m) _Pragma("unroll") for (int k = 0; k < 2; ++k) dst[m][k] = *(const LAS bf16x8*)(lds + PG8_SA(b, h) + aoff + m * 2048 + k * 1024); } while (0)
#define PG8_LDB(dst, b, h) do { _Pragma("unroll") for (int n = 0; n < 2; ++n) _Pragma("unroll") for (int k = 0; k < 2; ++k) dst[n][k] = *(const LAS bf16x8*)(lds + PG8_SB(b, h) + boff + n * 2048 + k * 1024); } while (0)
#define PG8_MMA(ai, bj, At, Bt_) do { __builtin_amdgcn_s_setprio(1); _Pragma("unroll") for (int m = 0; m < 4; ++m) _Pragma("unroll") for (int n = 0; n < 2; ++n) _Pragma("unroll") for (int k = 0; k < 2; ++k) \
        acc[ai][bj][m][n] = __builtin_amdgcn_mfma_f32_16x16x32_bf16(Bt_[n][k], At[m][k], acc[ai][bj][m][n], 0, 0, 0); __builtin_amdgcn_s_setprio(0); } while (0)
#define PG8_WAIT_V(n) asm volatile("s_waitcnt vmcnt(" #n ")" ::: "memory")
#define PG8_WAIT_L(n) asm volatile("s_waitcnt lgkmcnt(" #n ")" ::: "memory")
#define PG8_BAR __builtin_amdgcn_s_barrier()
#define PG8_SCHED __builtin_amdgcn_sched_barrier(0)
    f32x4 acc[2][2][4][2];
#pragma unroll
    for (int a_ = 0; a_ < 2; ++a_)
#pragma unroll
        for (int b_ = 0; b_ < 2; ++b_)
#pragma unroll
            for (int m = 0; m < 4; ++m)
#pragma unroll
                for (int n = 0; n < 2; ++n) acc[a_][b_][m][n] = (f32x4){0.f, 0.f, 0.f, 0.f};
    bf16x8 At[4][2], B0[2][2], B1[2][2];
    int pm = u / nN, pn = u - pm * nN;
    const char* cA = (const char*)A + (size_t)pm * tstep; const char* cB = (const char*)Bt + (size_t)pn * tstep;
    PG8_STAGEB(PG8_SB(0, 0), cB); PG8_STAGE(PG8_SA(0, 0), cA); PG8_STAGEB(PG8_SB(0, 1), cB + hstep); PG8_STAGE(PG8_SA(0, 1), cA + hstep);
    if (wr == 1) PG8_BAR;
    PG8_WAIT_V(4); PG8_BAR;
    PG8_STAGEB(PG8_SB(1, 0), cB + kstep); PG8_STAGE(PG8_SA(1, 0), cA + kstep); PG8_STAGEB(PG8_SB(1, 1), cB + hstep + kstep);
    PG8_WAIT_V(6); PG8_BAR;
    for (;;) {
        const int un = u + G; const bool has_next = un < nunits;
        const int npm = has_next ? un / nN : pm, npn = has_next ? un - npm * nN : pn;
        const char* nA = (const char*)A + (size_t)npm * tstep; const char* nB = (const char*)Bt + (size_t)npn * tstep;
        for (int t = 0; t < nt; t += 2) {
            const bool last = (t == nt - 2);
            const char* a1 = cA + (size_t)(t + 1) * kstep;
            const char* a2 = last ? nA : cA + (size_t)(t + 2) * kstep; const char* b2 = last ? nB : cB + (size_t)(t + 2) * kstep;
            const char* a3 = a2 + kstep; const char* b3 = b2 + kstep;
            PG8_LDB(B0, 0, 0); PG8_SCHED; PG8_LDA(At, 0, 0); PG8_STAGE(PG8_SA(1, 1), a1 + hstep);
            PG8_WAIT_L(8); PG8_BAR; PG8_WAIT_L(0); PG8_MMA(0, 0, At, B0); PG8_BAR; PG8_SCHED;
            PG8_LDB(B1, 0, 1); PG8_STAGEB(PG8_SB(0, 0), b2);
            PG8_BAR; PG8_WAIT_L(0); PG8_MMA(0, 1, At, B1); PG8_BAR;
            PG8_LDA(At, 0, 1); PG8_STAGE(PG8_SA(0, 0), a2);
            PG8_BAR; PG8_WAIT_L(0); PG8_MMA(1, 0, At, B0); PG8_BAR; PG8_SCHED;
            PG8_STAGEB(PG8_SB(0, 1), b2 + hstep);
            PG8_WAIT_V(6); PG8_BAR; PG8_MMA(1, 1, At, B1); PG8_BAR;
            PG8_LDB(B0, 1, 0); PG8_SCHED; PG8_LDA(At, 1, 0); PG8_STAGE(PG8_SA(0, 1), a2 + hstep);
            PG8_WAIT_L(8); PG8_BAR; PG8_WAIT_L(0); PG8_MMA(0, 0, At, B0); PG8_BAR; PG8_SCHED;
            PG8_LDB(B1, 1, 1); PG8_STAGEB(PG8_SB(1, 0), b3);
            PG8_BAR; PG8_WAIT_L(0); PG8_MMA(0, 1, At, B1); PG8_BAR;
            PG8_LDA(At, 1, 1); PG8_STAGE(PG8_SA(1, 0), a3);
            PG8_BAR; PG8_WAIT_L(0); PG8_MMA(1, 0, At, B0); PG8_BAR; PG8_SCHED;
            PG8_STAGEB(PG8_SB(1, 1), b3 + hstep);
            PG8_WAIT_V(6); PG8_BAR; PG8_MMA(1, 1, At, B1); PG8_BAR;
        }
        if constexpr (!Epi::AFTER_DRAIN) E.tile(acc, pm, pn, wr, wc, fr, fq);
        if (!has_next) break;
#pragma unroll
        for (int a_ = 0; a_ < 2; ++a_)
#pragma unroll
            for (int b_ = 0; b_ < 2; ++b_)
#pragma unroll
                for (int m = 0; m < 4; ++m)
#pragma unroll
                    for (int n = 0; n < 2; ++n) acc[a_][b_][m][n] = (f32x4){0.f, 0.f, 0.f, 0.f};
        u = un; pm = npm; pn = npn; cA = nA; cB = nB;
    }
    PG8_WAIT_V(0);
    if (wr == 0) PG8_BAR;
    PG8_BAR;
    if constexpr (Epi::AFTER_DRAIN) E.tile(acc, pm, pn, wr, wc, fr, fq);
#undef PG8_SA
#undef PG8_SB
#undef PG8_STAGE
#undef PG8_STAGEB
#undef PG8_STAGE_V
#undef PG8_LDA
#undef PG8_LDB
#undef PG8_MMA
#undef PG8_WAIT_V
#undef PG8_WAIT_L
#undef PG8_BAR
#undef PG8_SCHED
}

template <class Epi> struct RowEpi {
    static constexpr bool AFTER_DRAIN = false, PERM = true;
    const Epi& E;
    __device__ __forceinline__ void tile(f32x4 (&acc)[2][2][4][2], int pm, int pn, int wr, int wc, int fr, int fq) const {
        if constexpr (Epi::LIGHT_CTX) {
            typename Epi::Ctx ctx[2][4];
#pragma unroll
            for (int ai = 0; ai < 2; ++ai)
#pragma unroll
                for (int m = 0; m < 4; ++m) E.row_fetch(ctx[ai][m], (long)pm * 256 + ai * 128 + wr * 64 + m * 16 + fr, fq);
#pragma unroll
            for (int ai = 0; ai < 2; ++ai)
#pragma unroll
                for (int m = 0; m < 4; ++m) E.row_begin(ctx[ai][m], (long)pm * 256 + ai * 128 + wr * 64 + m * 16 + fr, fq);
#pragma unroll
            for (int ai = 0; ai < 2; ++ai)
#pragma unroll
                for (int m = 0; m < 4; ++m) {
                    const long row = (long)pm * 256 + ai * 128 + wr * 64 + m * 16 + fr;
#pragma unroll
                    for (int bj = 0; bj < 2; ++bj) E.pair8(ctx[ai][m], bj, row, pn * 256 + bj * 128 + wc * 32 + 8 * fq, acc[ai][bj][m][0], acc[ai][bj][m][1]);
                    E.row_end(ctx[ai][m], row, pn * 4 + wc, fq);
                }
        } else {
#pragma unroll
        for (int ai = 0; ai < 2; ++ai) {
            typename Epi::Ctx ctx[4];
#pragma unroll
            for (int m = 0; m < 4; ++m) {
                const long row = (long)pm * 256 + ai * 128 + wr * 64 + m * 16 + fr;
                E.row_fetch(ctx[m], row, fq);
#pragma unroll
                for (int bj = 0; bj < 2; ++bj) E.preload(ctx[m], bj, row, pn * 256 + bj * 128 + wc * 32 + 8 * fq);
            }
#pragma unroll
            for (int m = 0; m < 4; ++m) E.row_begin(ctx[m], (long)pm * 256 + ai * 128 + wr * 64 + m * 16 + fr, fq);
#pragma unroll
            for (int m = 0; m < 4; ++m) {
                const long row = (long)pm * 256 + ai * 128 + wr * 64 + m * 16 + fr;
#pragma unroll
                for (int bj = 0; bj < 2; ++bj) E.pair8(ctx[m], bj, row, pn * 256 + bj * 128 + wc * 32 + 8 * fq, acc[ai][bj][m][0], acc[ai][bj][m][1]);
                E.row_end(ctx[m], row, pn * 4 + wc, fq);
            }
        }
        }
        asm volatile("s_waitcnt vmcnt(0)" ::: "memory");
    }
};
template <class Epi>
__device__ __forceinline__ void gemm_phase(const int wv, const bf16_t* A, const bf16_t* Bt, int nN, const Epi& E, unsigned char* lds, const int gx, const int gt) {
    asm volatile("; ==== PHASE gemm");
    const int tid = opaque_tid(wv);
    const bool xmap = (gridDim.x & 7) == 0;
    const int U8 = 8 * nN, G8 = (int)gridDim.x >> 3;
    const int bu0 = xmap ? gx * U8 + gt : (int)blockIdx.x, bus = xmap ? G8 : (int)gridDim.x, bub = xmap ? (gx + 1) * U8 : 64 * nN;
    for (int xr = 0; xr < ((XPROBE == 1 && Epi::IDEMPOTENT) ? 2 : 1); ++xr)
    gemm256_units(tid, (LAS unsigned char*)lds, A, Bt, nN, bu0, bus, bub, RowEpi<Epi>{E});
    const int wid = tid >> 6, lane = tid & 63, fr = lane & 15, fq = lane >> 4;
    const int nct = 4 * nN, nsmall = 8 * nct;
    unsigned voff, voffb; { int R, C; stage_rc(tid * 16, R, C); voff = (unsigned)(R * 1024 + C) * 2u; voffb = (unsigned)(((R & ~31) + perm32(R & 31)) * 1024 + C) * 2u; }
    const int remu = U8 % G8, nlight = (xmap && remu) ? (G8 - remu) * 8 : (int)gridDim.x;
    const int sidx = xmap ? (G8 - 1 - gt) * 8 + gx : (int)gridDim.x - 1 - (int)blockIdx.x;
    for (int xr = 0; xr < ((XPROBE == 2 && Epi::IDEMPOTENT) ? 2 : 1); ++xr)
    for (int us = sidx < nlight ? sidx : nsmall; us < nsmall; us += nlight) {
        const int rt = us / nct, ct = us - rt * nct;
        const unsigned char* ag = (const unsigned char*)(A + ((long)TP + 64 * rt) * 1024) + voff;
        const unsigned char* bg = (const unsigned char*)(Bt + (long)(64 * ct) * 1024) + voffb;
        auto issue = [&](int kt) {
            unsigned char* slot = lds + (kt & 7) * 16384;
            __builtin_amdgcn_global_load_lds((const unsigned*)(ag + kt * 128), (unsigned*)(slot + tid * 16), 16, 0, 0);
            __builtin_amdgcn_global_load_lds((const unsigned*)(bg + kt * 128), (unsigned*)(slot + 8192 + tid * 16), 16, 0, 0);
        };
        f32x4 acc[4];
#pragma unroll
        for (int n = 0; n < 4; ++n) acc[n] = (f32x4){0.f, 0.f, 0.f, 0.f};
#pragma unroll
        for (int kt = 0; kt < 7; ++kt) issue(kt);
#pragma unroll
        for (int t = 0; t < 16; ++t) {
            const int younger = (15 - t) < 6 ? (15 - t) : 6;
            if (younger == 6) asm volatile("s_waitcnt vmcnt(12)" ::: "memory");
            else if (younger == 5) asm volatile("s_waitcnt vmcnt(10)" ::: "memory");
            else if (younger == 4) asm volatile("s_waitcnt vmcnt(8)" ::: "memory");
            else if (younger == 3) asm volatile("s_waitcnt vmcnt(6)" ::: "memory");
            else if (younger == 2) asm volatile("s_waitcnt vmcnt(4)" ::: "memory");
            else if (younger == 1) asm volatile("s_waitcnt vmcnt(2)" ::: "memory");
            else asm volatile("s_waitcnt vmcnt(0)" ::: "memory");
            wg_barrier();
            if (t + 7 < 16) issue(t + 7);
            if (wid < 4) {
                const unsigned char* Ab = lds + (t & 7) * 16384; const unsigned char* Bb = Ab + 8192;
#pragma unroll
                for (int k = 0; k < 2; ++k) {
                    const bf16x8 a = *(const bf16x8*)(Ab + lds_byte(16 * wid + fr, 32 * k + 8 * fq));
#pragma unroll
                    for (int n = 0; n < 4; ++n) acc[n] = mfma16(*(const bf16x8*)(Bb + lds_byte(16 * n + fr, 32 * k + 8 * fq)), a, acc[n]);
                }
            }
        }
        lds_barrier();
        if (wid < 4) {
            const long row = (long)TP + 64 * rt + 16 * wid + fr; const int col0 = 64 * ct + 8 * fq;
            typename Epi::Ctx ctx; E.row_fetch(ctx, row, fq);
            E.preload(ctx, 0, row, col0); E.preload(ctx, 1, row, col0 + 32);
            E.row_begin(ctx, row, fq);
            E.pair8(ctx, 0, row, col0, acc[0], acc[1]);
            E.pair8(ctx, 1, row, col0 + 32, acc[2], acc[3]);
            E.row_end(ctx, row, ct, fq);
        }
    }
    if constexpr (Epi::CONVERT) {
        if (xmap && remu != 0 && sidx < nlight) convert_tables(E.p, wid, lane, 2 * E.j, sidx, nlight, 0, CVT_QKV_UNITS);
    }
}

struct EpiQKV {
    static constexpr bool IDEMPOTENT = true, CONVERT = true, LIGHT_CTX = true;
    const Params& p; int j;
    struct Ctx { float rs; int ko, vo; f32x4 part; };
    __device__ __forceinline__ void row_fetch(Ctx& c, long row, int fq) const { c.part = row_ssq_q(p.ssq(), row, fq); }
    __device__ __forceinline__ void preload(Ctx&, int, long, int) const {}
    __device__ __forceinline__ void row_begin(Ctx& c, long row, int fq) const {
        c.rs = row_rstd_q(c.part);
        int ko = -1, vo = -1;
        if (row < TP) { const int s = (int)(row & 4095); if (s >= 3968) { const int r = ((j * 4 + (int)(row >> 12)) * 128 + (s - 3968)) * 256; ko = (int)O_KP + r; vo = (int)O_VP + r; } }
        else { const int ts = (int)(row - TP); const int r = ((j * 128 + (ts >> 2)) * 128 + 124 + (ts & 3)) * 256; ko = (int)O_KS + r; vo = (int)O_VS + r; }
        c.ko = ko; c.vo = vo;
    }
    __device__ __forceinline__ void pair8(const Ctx& c, int, long row, int col, f32x4 a0, f32x4 a1) const {
        const f32x4 v0 = a0 * c.rs, v1 = a1 * c.rs;
        u32x4 w; w.x = pk_bf16(v0[0], v0[1]); w.y = pk_bf16(v0[2], v0[3]); w.z = pk_bf16(v1[0], v1[1]); w.w = pk_bf16(v1[2], v1[3]);
        if (col < 1024) *(u32x4*)(p.q() + row * 1024 + col) = w;
        else if (col < 1280) { *(u32x4*)(p.k() + row * 256 + (col - 1024)) = w; if (c.ko >= 0) { float* o = p.out + (unsigned)(c.ko + (col - 1024)); __builtin_nontemporal_store(v0, (f32x4*)o); __builtin_nontemporal_store(v1, (f32x4*)(o + 4)); } }
        else { *(u32x4*)(p.v() + row * 256 + (col - 1280)) = w; if (c.vo >= 0) { float* o = p.out + (unsigned)(c.vo + (col - 1280)); __builtin_nontemporal_store(v0, (f32x4*)o); __builtin_nontemporal_store(v1, (f32x4*)(o + 4)); } }
    }
    __device__ __forceinline__ void row_end(Ctx&, long, int, int) const {}
};

struct EpiRes {
    static constexpr bool IDEMPOTENT = false, CONVERT = false, LIGHT_CTX = false;
    const bf16_t* hin; bf16_t* hbout; float* ssqout;
    struct Ctx { float ss; u32x4 hw[2]; };
    __device__ __forceinline__ void row_fetch(Ctx&, long, int) const {}
    __device__ __forceinline__ void row_begin(Ctx& c, long, int) const { c.ss = 0.f; }
    __device__ __forceinline__ void preload(Ctx& c, int k, long row, int col) const { c.hw[k] = *(const u32x4*)(hin + row * 1024 + col); }
    __device__ __forceinline__ void pair8(Ctx& c, int k, long row, int col, f32x4 a0, f32x4 a1) const {
        const u32x4 hw = c.hw[k];
        const f32x4 v0 = (f32x4){bflo(hw.x), bfhi(hw.x), bflo(hw.y), bfhi(hw.y)} + a0, v1 = (f32x4){bflo(hw.z), bfhi(hw.z), bflo(hw.w), bfhi(hw.w)} + a1;
        u32x4 w; w.x = pk_bf16(v0[0], v0[1]); w.y = pk_bf16(v0[2], v0[3]); w.z = pk_bf16(v1[0], v1[1]); w.w = pk_bf16(v1[2], v1[3]);
        *(u32x4*)(hbout + row * 1024 + col) = w;
        c.ss += ((v0[0] * v0[0] + v0[1] * v0[1]) + (v0[2] * v0[2] + v0[3] * v0[3])) + ((v1[0] * v1[0] + v1[1] * v1[1]) + (v1[2] * v1[2] + v1[3] * v1[3]));
    }
    __device__ __forceinline__ void row_end(Ctx& c, long row, int part, int fq) const {
        float ss = c.ss; ss += __shfl_xor(ss, 16); ss += __shfl_xor(ss, 32);
        if (fq == 0) ssqout[row * 16 + part] = ss;
    }
};

struct EpiWin {
    static constexpr bool IDEMPOTENT = true, CONVERT = false, LIGHT_CTX = false;
    const Params& p; int j;
    struct Ctx { float rs; int co; f32x4 part; };
    __device__ __forceinline__ void row_fetch(Ctx& c, long row, int fq) const { c.part = row_ssq_q(p.ssq(), row, fq); }
    __device__ __forceinline__ void preload(Ctx&, int, long, int) const {}
    __device__ __forceinline__ void row_begin(Ctx& c, long row, int fq) const {
        c.rs = row_rstd_q(c.part); int co = -1;
        if (row < TP) { const int s = (int)(row & 4095); if (s >= 4094) co = (int)O_CP + ((j * 4 + (int)(row >> 12)) * 2 + (s - 4094)) * 1024; }
        else { const int ts = (int)(row - TP); if ((ts & 3) >= 2) co = (int)O_CS + ((j * 128 + (ts >> 2)) * 2 + ((ts & 3) - 2)) * 1024; }
        c.co = co;
    }
    __device__ __forceinline__ void pair8(Ctx& c, int, long row, int col, f32x4 a0, f32x4 a1) const {
        if (col < 1024) {
            const f32x4 v0 = a0 * c.rs, v1 = a1 * c.rs;
            u32x4 w; w.x = pk_bf16(v0[0], v0[1]); w.y = pk_bf16(v0[2], v0[3]); w.z = pk_bf16(v1[0], v1[1]); w.w = pk_bf16(v1[2], v1[3]);
            *(u32x4*)(p.bg() + row * 1024 + col) = w;
        } else {
            const int ch = (col - 1024) >> 1;
            const f32x4 u = (a0 * c.rs) * (a1 * c.rs);
            u32x2 w; w.x = pk_bf16(u[0], u[1]); w.y = pk_bf16(u[2], u[3]);
            *(u32x2*)(p.ub() + row * 1024 + ch) = w;
            if (c.co >= 0) __builtin_nontemporal_store(u, (f32x4*)(p.out + (unsigned)(c.co + ch)));
        }
    }
    __device__ __forceinline__ void row_end(Ctx&, long, int, int) const {}
};

__device__ __forceinline__ void attn_core(const unsigned char* Ks, const unsigned char* Vt, int vstride, int kb0, bf16x8 q0, bf16x8 q1,
                                          const float* btab_h, int dbase, int cmin, int cmax, float sink, int fr, int fq, f32x4 (&o)[4]) {
    f32x4 s[10];
#pragma unroll
    for (int kb = 0; kb < 10; ++kb) {
        const unsigned char* kr = Ks + (16 * (kb0 + kb) + fr) * 144 + 16 * fq;
        bf16x8 a0 = *(const bf16x8*)kr, a1 = *(const bf16x8*)(kr + 64);
        f32x4 z = (f32x4){0.f, 0.f, 0.f, 0.f};
        z = mfma16(a0, q0, z); z = mfma16(a1, q1, z);
        s[kb] = z;
        if (kb == 4) __builtin_amdgcn_sched_barrier(0);
    }
    float m = sink;
#pragma unroll
    for (int kb = 0; kb < 10; ++kb)
#pragma unroll
        for (int jj = 0; jj < 4; ++jj) {
            const int c = 16 * (kb0 + kb) + 4 * fq + jj; const int dist = dbase - c;
            const bool valid = dist >= 0 && dist < 128 && c >= cmin && c < cmax;
            const float bias = btab_h[dist & 127];
            const float sv = valid ? s[kb][jj] * 0.125f + bias : -1e30f;
            s[kb][jj] = sv; m = fmaxf(m, sv);
        }
    m = fmaxf(m, __shfl_xor(m, 16)); m = fmaxf(m, __shfl_xor(m, 32));
    float l = 0.f;
#pragma unroll
    for (int kb = 0; kb < 10; ++kb)
#pragma unroll
        for (int jj = 0; jj < 4; ++jj) { const float sv = s[kb][jj]; const float pe = sv > -1e29f ? __expf(sv - m) : 0.f; s[kb][jj] = pe; l += pe; }
    l += __shfl_xor(l, 16); l += __shfl_xor(l, 32);
    l += __expf(sink - m);
    const float inv = 1.0f / l;
    bf16x8 pb[5];
#pragma unroll
    for (int kk = 0; kk < 5; ++kk) {
        u32x4 w; w.x = pk_bf16(s[2 * kk][0], s[2 * kk][1]); w.y = pk_bf16(s[2 * kk][2], s[2 * kk][3]); w.z = pk_bf16(s[2 * kk + 1][0], s[2 * kk + 1][1]); w.w = pk_bf16(s[2 * kk + 1][2], s[2 * kk + 1][3]);
        pb[kk] = __builtin_bit_cast(bf16x8, w);
    }
#pragma unroll
    for (int db = 0; db < 4; ++db) {
        f32x4 z = (f32x4){0.f, 0.f, 0.f, 0.f};
#pragma unroll
        for (int kk = 0; kk < 5; ++kk) {
            const unsigned char* vr = Vt + (16 * db + fr) * vstride + (16 * (kb0 + 2 * kk) + 4 * fq) * 2;
            u32x2 lo = *(const u32x2*)vr, hi = *(const u32x2*)(vr + 32);
            u32x4 w; w.x = lo.x; w.y = lo.y; w.z = hi.x; w.w = hi.y;
            z = mfma16(__builtin_bit_cast(bf16x8, w), pb[kk], z);
        }
        o[db] = z * inv;
    }
}
__device__ __forceinline__ void attn_core_l2(const unsigned char* Ks, const unsigned char* Vt, int vstride, int kb0, bf16x8 q0, bf16x8 q1,
                                          const float* btab_h, int dbase, int cmin, int cmax, float sink, int fr, int fq, f32x4 (&o)[4]) {
    f32x4 s[10];
#pragma unroll
    for (int kb = 0; kb < 10; ++kb) {
        const unsigned char* kr = Ks + (16 * (kb0 + kb) + fr) * 144 + 16 * fq;
        bf16x8 a0 = *(const bf16x8*)kr, a1 = *(const bf16x8*)(kr + 64);
        f32x4 z = (f32x4){0.f, 0.f, 0.f, 0.f};
        z = mfma16(a0, q0, z); z = mfma16(a1, q1, z);
        s[kb] = z;
        if (kb == 4) __builtin_amdgcn_sched_barrier(0);
    }
    float m = sink;
#pragma unroll
    for (int kb = 0; kb < 10; ++kb)
#pragma unroll
        for (int jj = 0; jj < 4; ++jj) {
            const int c = 16 * (kb0 + kb) + 4 * fq + jj; const int dist = dbase - c;
            const bool valid = dist >= 0 && dist < 128 && c >= cmin && c < cmax;
            const float bias = btab_h[dist & 127];
            const float sv = valid ? s[kb][jj] * 0.18033688f + bias : -1e30f;
            s[kb][jj] = sv; m = fmaxf(m, sv);
        }
    m = fmaxf(m, __shfl_xor(m, 16)); m = fmaxf(m, __shfl_xor(m, 32));
    float l = 0.f;
#pragma unroll
    for (int kb = 0; kb < 10; ++kb)
#pragma unroll
        for (int jj = 0; jj < 4; ++jj) { const float pe = __builtin_amdgcn_exp2f(s[kb][jj] - m); s[kb][jj] = pe; l += pe; }
    l += __shfl_xor(l, 16); l += __shfl_xor(l, 32);
    l += __builtin_amdgcn_exp2f(sink - m);
    const float inv = 1.0f / l;
    bf16x8 pb[5];
#pragma unroll
    for (int kk = 0; kk < 5; ++kk) {
        u32x4 w; w.x = pk_bf16(s[2 * kk][0], s[2 * kk][1]); w.y = pk_bf16(s[2 * kk][2], s[2 * kk][3]); w.z = pk_bf16(s[2 * kk + 1][0], s[2 * kk + 1][1]); w.w = pk_bf16(s[2 * kk + 1][2], s[2 * kk + 1][3]);
        pb[kk] = __builtin_bit_cast(bf16x8, w);
    }
#pragma unroll
    for (int db = 0; db < 4; ++db) {
        f32x4 z = (f32x4){0.f, 0.f, 0.f, 0.f};
#pragma unroll
        for (int kk = 0; kk < 5; ++kk) {
            const unsigned char* vr = Vt + (16 * db + fr) * vstride + (16 * (kb0 + 2 * kk) + 4 * fq) * 2;
            u32x2 lo = *(const u32x2*)vr, hi = *(const u32x2*)(vr + 32);
            u32x4 w; w.x = lo.x; w.y = lo.y; w.z = hi.x; w.w = hi.y;
            z = mfma16(__builtin_bit_cast(bf16x8, w), pb[kk], z);
        }
        o[db] = z * inv;
    }
}
__device__ __forceinline__ void attn_core_9(const unsigned char* Ks, const unsigned char* Vt, int vstride, int kb0, bf16x8 q0, bf16x8 q1,
                                          const float* btab_h, int dbase, int cmin, int cmax, float sink, int fr, int fq, f32x4 (&o)[4]) {
    f32x4 s[9];
#pragma unroll
    for (int kb = 0; kb < 9; ++kb) {
        const unsigned char* kr = Ks + (16 * (kb0 + kb) + fr) * 144 + 16 * fq;
        bf16x8 a0 = *(const bf16x8*)kr, a1 = *(const bf16x8*)(kr + 64);
        f32x4 z = (f32x4){0.f, 0.f, 0.f, 0.f};
        z = mfma16(a0, q0, z); z = mfma16(a1, q1, z);
        s[kb] = z;
        if (kb == 4) __builtin_amdgcn_sched_barrier(0);
    }
    float m = sink;
#pragma unroll
    for (int kb = 0; kb < 9; ++kb)
#pragma unroll
        for (int jj = 0; jj < 4; ++jj) {
            const int c = 16 * (kb0 + kb) + 4 * fq + jj; const int dist = dbase - c;
            const bool valid = dist >= 0 && dist < 128 && c >= cmin && c < cmax;
            const float bias = btab_h[dist & 127];
            const float sv = valid ? s[kb][jj] * 0.18033688f + bias : -1e30f;
            s[kb][jj] = sv; m = fmaxf(m, sv);
        }
    m = fmaxf(m, __shfl_xor(m, 16)); m = fmaxf(m, __shfl_xor(m, 32));
    float l = 0.f;
#pragma unroll
    for (int kb = 0; kb < 9; ++kb)
#pragma unroll
        for (int jj = 0; jj < 4; ++jj) { const float pe = __builtin_amdgcn_exp2f(s[kb][jj] - m); s[kb][jj] = pe; l += pe; }
    l += __shfl_xor(l, 16); l += __shfl_xor(l, 32);
    l += __builtin_amdgcn_exp2f(sink - m);
    const float inv = 1.0f / l;
    bf16x8 pb[4];
#pragma unroll
    for (int kk = 0; kk < 4; ++kk) {
        u32x4 w; w.x = pk_bf16(s[2 * kk][0], s[2 * kk][1]); w.y = pk_bf16(s[2 * kk][2], s[2 * kk][3]); w.z = pk_bf16(s[2 * kk + 1][0], s[2 * kk + 1][1]); w.w = pk_bf16(s[2 * kk + 1][2], s[2 * kk + 1][3]);
        pb[kk] = __builtin_bit_cast(bf16x8, w);
    }
    u32x4 w8; w8.x = pk_bf16(s[8][0], s[8][1]); w8.y = pk_bf16(s[8][2], s[8][3]); w8.z = 0u; w8.w = 0u;
    const bf16x8 pb8 = __builtin_bit_cast(bf16x8, w8);
#pragma unroll
    for (int db = 0; db < 4; ++db) {
        f32x4 z = (f32x4){0.f, 0.f, 0.f, 0.f};
#pragma unroll
        for (int kk = 0; kk < 4; ++kk) {
            const unsigned char* vr = Vt + (16 * db + fr) * vstride + (16 * (kb0 + 2 * kk) + 4 * fq) * 2;
            u32x2 lo = *(const u32x2*)vr, hi = *(const u32x2*)(vr + 32);
            u32x4 w; w.x = lo.x; w.y = lo.y; w.z = hi.x; w.w = hi.y;
            z = mfma16(__builtin_bit_cast(bf16x8, w), pb[kk], z);
        }
        { const u32x2 lo = *(const u32x2*)(Vt + (16 * db + fr) * vstride + (16 * (kb0 + 8) + 4 * fq) * 2); u32x4 w; w.x = lo.x; w.y = lo.y; w.z = lo.x; w.w = lo.y; z = mfma16(__builtin_bit_cast(bf16x8, w), pb8, z); }
        o[db] = z * inv;
    }
}
__device__ __forceinline__ void attn_core_h(const unsigned char* Ks, const unsigned char* Vt, int vstride, int kb0, bf16x8 q0, bf16x8 q1,
                                          const float (&be)[9][4], int cmin, float sink, int fr, int fq, f32x4 (&o)[4]) {
    f32x4 s[9];
#pragma unroll
    for (int kb = 0; kb < 9; ++kb) {
        const unsigned char* kr = Ks + (16 * (kb0 + kb) + fr) * 144 + 16 * fq;
        bf16x8 a0 = *(const bf16x8*)kr, a1 = *(const bf16x8*)(kr + 64);
        f32x4 z = (f32x4){0.f, 0.f, 0.f, 0.f};
        z = mfma16(a0, q0, z); z = mfma16(a1, q1, z);
        s[kb] = z;
        if (kb == 4) __builtin_amdgcn_sched_barrier(0);
    }
    float m = sink;
#pragma unroll
    for (int kb = 0; kb < 9; ++kb)
#pragma unroll
        for (int jj = 0; jj < 4; ++jj) {
            const int c = 16 * (kb0 + kb) + 4 * fq + jj;
            const float sv0 = __builtin_fmaf(s[kb][jj], 0.18033688f, be[kb][jj]);
            const float sv = c >= cmin ? sv0 : -1e30f;
            s[kb][jj] = sv; m = fmaxf(m, sv);
        }
    m = fmaxf(m, __shfl_xor(m, 16)); m = fmaxf(m, __shfl_xor(m, 32));
    float l = 0.f;
#pragma unroll
    for (int kb = 0; kb < 9; ++kb)
#pragma unroll
        for (int jj = 0; jj < 4; ++jj) { const float pe = __builtin_amdgcn_exp2f(s[kb][jj] - m); s[kb][jj] = pe; l += pe; }
    l += __shfl_xor(l, 16); l += __shfl_xor(l, 32);
    l += __builtin_amdgcn_exp2f(sink - m);
    const float inv = 1.0f / l;
    bf16x8 pb[4];
#pragma unroll
    for (int kk = 0; kk < 4; ++kk) {
        u32x4 w; w.x = pk_bf16(s[2 * kk][0], s[2 * kk][1]); w.y = pk_bf16(s[2 * kk][2], s[2 * kk][3]); w.z = pk_bf16(s[2 * kk + 1][0], s[2 * kk + 1][1]); w.w = pk_bf16(s[2 * kk + 1][2], s[2 * kk + 1][3]);
        pb[kk] = __builtin_bit_cast(bf16x8, w);
    }
    u32x4 w8; w8.x = pk_bf16(s[8][0], s[8][1]); w8.y = pk_bf16(s[8][2], s[8][3]); w8.z = 0u; w8.w = 0u;
    const bf16x8 pb8 = __builtin_bit_cast(bf16x8, w8);
#pragma unroll
    for (int db = 0; db < 4; ++db) {
        f32x4 z = (f32x4){0.f, 0.f, 0.f, 0.f};
#pragma unroll
        for (int kk = 0; kk < 4; ++kk) {
            const unsigned char* vr = Vt + (16 * db + fr) * vstride + (16 * (kb0 + 2 * kk) + 4 * fq) * 2;
            u32x2 lo = *(const u32x2*)vr, hi = *(const u32x2*)(vr + 32);
            u32x4 w; w.x = lo.x; w.y = lo.y; w.z = hi.x; w.w = hi.y;
            z = mfma16(__builtin_bit_cast(bf16x8, w), pb[kk], z);
        }
        { const u32x2 lo = *(const u32x2*)(Vt + (16 * db + fr) * vstride + (16 * (kb0 + 8) + 4 * fq) * 2); u32x4 w; w.x = lo.x; w.y = lo.y; w.z = lo.x; w.w = lo.y; z = mfma16(__builtin_bit_cast(bf16x8, w), pb8, z); }
        o[db] = z * inv;
    }
}

__device__ __forceinline__ void attn_phase(const int wv, const Params& p, int j, unsigned char* lds) {
    asm volatile("; ==== PHASE attn");
    const int tid = opaque_tid(wv), wid = tid >> 6, lane = tid & 63, fr = lane & 15, fq = lane >> 4;
    int bid = blockIdx.x; asm volatile("" : "+s"(bid));
    u32x4 kreg[4], vreg[4]; float rbv;
    const int bkt = kBucket[tid & 127];
    auto kv_load = [&](int u) {
        const int b = u >> 7, n = (u >> 2) & 31, kvh = u & 3;
        {   const int row = tid >> 1, half = tid & 1;
            const long tok = (long)b * 4096 + (long)(n - 1) * 128 + row;
            const bool ok = !(n == 0 && row < 128);
            const u32x4* src = (const u32x4*)(p.k() + (ok ? tok : 0) * 256 + kvh * 64 + half * 32);
#pragma unroll
            for (int i = 0; i < 4; ++i) { const u32x4 w = src[i]; kreg[i] = ok ? w : w ^ w; } }
        {   const int key = tid & 255, dp = tid >> 8;
            const long tok = (long)b * 4096 + (long)(n - 1) * 128 + key;
            const bool ok = !(n == 0 && key < 128);
            const u32x4* src = (const u32x4*)(p.v() + (ok ? tok : 0) * 256 + kvh * 64 + dp * 32);
#pragma unroll
            for (int i = 0; i < 4; ++i) { const u32x4 w = src[i]; vreg[i] = ok ? w : w ^ w; } }
        rbv = p.rel_bias[bkt * 16 + kvh * 4 + (tid >> 7)];
    };
    if (bid < 512) kv_load(bid);
    int u = bid;
    for (; u < 512; u += gridDim.x) {
        {
            const int b = u >> 7, n = (u >> 2) & 31, kvh = u & 3;
            unsigned char* Ks = lds; unsigned char* Vt = lds + 36864; float* btab = (float*)(lds + 70656);
            const int g = wid & 3, qh = wid >> 2, head = kvh * 4 + g;
            const bf16_t* qbase = p.q() + ((long)b * 4096 + n * 128 + 64 * qh + fr) * 1024 + head * 64 + 8 * fq;
            bf16x8 q0 = *(const bf16x8*)qbase, q1 = *(const bf16x8*)(qbase + 32);
            {   const int row = tid >> 1, half = tid & 1;
                u32x4* dst = (u32x4*)(Ks + row * 144 + half * 64);
#pragma unroll
                for (int i = 0; i < 4; ++i) dst[i] = kreg[i]; }
            {   const int key = tid & 255, dp = tid >> 8;
#pragma unroll
                for (int i = 0; i < 4; ++i) {
                    const u32x4 w = vreg[i];
                    bf16_t* dst = (bf16_t*)(Vt + (dp * 32 + 8 * i) * 528 + key * 2);
#pragma unroll
                    for (int e = 0; e < 4; ++e) { dst[(2 * e) * 264] = (bf16_t)(w[e] & 0xffffu); dst[(2 * e + 1) * 264] = (bf16_t)(w[e] >> 16); }
                } }
            { const int hl = tid >> 7, dist = tid & 127; btab[hl * 128 + dist] = rbv * 1.44269504f; }
            lds_barrier();
            if (u + (int)gridDim.x < 512) kv_load(u + (int)gridDim.x);
            const float sink = p.sinks[j * 16 + head] * 1.44269504f;
            float be[9][4];
#pragma unroll
            for (int kb = 0; kb < 9; ++kb)
#pragma unroll
                for (int jj = 0; jj < 4; ++jj) { const int dist = 128 + fr - 16 * kb - 4 * fq - jj; const float bv = btab[g * 128 + (dist & 127)]; be[kb][jj] = (dist >= 0 && dist < 128) ? bv : -1e30f; }
#pragma unroll 1
            for (int qb = 0; qb < 4; ++qb) {
                const int r0 = 64 * qh + 16 * qb;
                const long tokq = (long)b * 4096 + n * 128 + r0 + fr;
                const int a = r0 >> 4; const int kb0 = a;
                const bf16_t* qn = qbase + (long)(qb < 3 ? 16 * (qb + 1) : 0) * 1024;
                const bf16x8 n0 = *(const bf16x8*)qn, n1 = *(const bf16x8*)(qn + 32);
                __builtin_amdgcn_sched_barrier(0);
                f32x4 o[4];
                attn_core_h(Ks, Vt, 528, kb0, q0, q1, be, n == 0 ? 128 : 0, sink, fr, fq, o);
#pragma unroll
                for (int db = 0; db < 4; ++db) { u32x2 w; w.x = pk_bf16(o[db][0], o[db][1]); w.y = pk_bf16(o[db][2], o[db][3]); *(u32x2*)(p.o() + tokq * 1024 + head * 64 + 16 * db + 4 * fq) = w; }
                q0 = n0; q1 = n1;
            }
            lds_barrier();
        }
    }
    for (; u < 768; u += gridDim.x) {
        {
            const int su = u - 512, b = su >> 1, kvp = su & 1;
            float* btab = (float*)(lds + 89088);
#pragma unroll
            for (int ib = 0; ib < 2; ++ib) {
                f32x4 kxs[4], vxs[4];
#pragma unroll
                for (int ii = 0; ii < 4; ++ii) {
                    const int e = tid + 512 * (4 * ib + ii); const int kl = e >> 11, c = (e >> 4) & 127, d = (e & 15) * 4;
                    const long off = ((long)(j * 128 + b) * 128 + c) * 256 + (2 * kvp + kl) * 64 + d;
                    kxs[ii] = __builtin_nontemporal_load((const f32x4*)(p.cache_k + off)); vxs[ii] = __builtin_nontemporal_load((const f32x4*)(p.cache_v + off));
                }
                __builtin_amdgcn_sched_barrier(0);
#pragma unroll
                for (int ii = 0; ii < 4; ++ii) {
                    const int e = tid + 512 * (4 * ib + ii); const int kl = e >> 11, c = (e >> 4) & 127, d = (e & 15) * 4;
                    const long off = ((long)(j * 128 + b) * 128 + c) * 256 + (2 * kvp + kl) * 64 + d;
                    const f32x4 kx = kxs[ii], vx = vxs[ii];
                    u32x2 w; w.x = pk_bf16(kx[0], kx[1]); w.y = pk_bf16(kx[2], kx[3]);
                    *(u32x2*)(lds + kl * 44544 + c * 144 + d * 2) = w;
                    bf16_t* vd = (bf16_t*)(lds + kl * 44544 + 23040 + d * 336 + c * 2);
                    vd[0] = f2bf(vx[0]); vd[168] = f2bf(vx[1]); vd[336] = f2bf(vx[2]); vd[504] = f2bf(vx[3]);
                }
            }
            {
                const int kl = tid >> 8, cc = (tid >> 6) & 3, d = tid & 63;
                const long tok = TP + b * 4 + cc;
                *(bf16_t*)(lds + kl * 44544 + (128 + cc) * 144 + d * 2) = p.k()[tok * 256 + (2 * kvp + kl) * 64 + d];
                *(bf16_t*)(lds + kl * 44544 + 23040 + d * 336 + (128 + cc) * 2) = p.v()[tok * 256 + (2 * kvp + kl) * 64 + d];
            }
            for (int e = tid; e < 2 * 28 * 64; e += NTHREADS) {
                const int kl = e / (28 * 64), r = e % (28 * 64), c = 132 + r / 64, d = r % 64;
                *(bf16_t*)(lds + kl * 44544 + c * 144 + d * 2) = 0;
                *(bf16_t*)(lds + kl * 44544 + 23040 + d * 336 + c * 2) = 0;
            }
            for (int e = tid; e < 1024; e += NTHREADS) { const int hl = e >> 7; btab[e] = p.rel_bias[bkt * 16 + kvp * 8 + hl]; }
            lds_barrier();
            if (wid < 2) {
                const int kl = wid, kvh = 2 * kvp + kl, g = fr >> 2, jt = fr & 3, head = kvh * 4 + g;
                const long tok = TP + b * 4 + jt;
                const bf16_t* qp = p.q() + tok * 1024 + head * 64 + 8 * fq;
                bf16x8 q0 = *(const bf16x8*)qp, q1 = *(const bf16x8*)(qp + 32);
                const float sink = p.sinks[j * 16 + head];
                f32x4 o[4];
                attn_core(lds + kl * 44544, lds + kl * 44544 + 23040, 336, 0, q0, q1, btab + (kl * 4 + g) * 128, jt + 128, 0, 132, sink, fr, fq, o);
#pragma unroll
                for (int db = 0; db < 4; ++db) { u32x2 w; w.x = pk_bf16(o[db][0], o[db][1]); w.y = pk_bf16(o[db][2], o[db][3]); *(u32x2*)(p.o() + tok * 1024 + head * 64 + 16 * db + 4 * fq) = w; }
            }
            lds_barrier();
        }
    }
}

__device__ __forceinline__ void convz_phase(const int wv, const Params& p, int j) {
    asm volatile("; ==== PHASE convz");
    const float* cw = p.conv_w + j * 3 * 1024;
    const int tid = opaque_tid(wv);
    const int c8 = (tid & 127) * 8;
    float w0[8], w1[8], w2[8];
#pragma unroll
    for (int i = 0; i < 8; ++i) { w0[i] = cw[c8 + i]; w1[i] = cw[1024 + c8 + i]; w2[i] = cw[2048 + c8 + i]; }
    const long S = (long)gridDim.x * 4;
    auto cz_load = [&](long t0, u32x4 (&bw)[4], u32x4 (&u0)[4], u32x4 (&r1)[4], u32x4 (&r2)[4]) {
#pragma unroll
        for (int q = 0; q < 4; ++q) {
            const long t = t0 + q * S, tc = t < TP ? t : TP - 1; const int s = (int)(tc & 4095);
            bw[q] = *(const u32x4*)(p.bg() + tc * 1024 + c8);
            u0[q] = *(const u32x4*)(p.ub() + tc * 1024 + c8);
            r1[q] = *(const u32x4*)(p.ub() + (tc - (s >= 1 ? 1 : 0)) * 1024 + c8);
            r2[q] = *(const u32x4*)(p.ub() + (tc - (s >= 2 ? 2 : 0)) * 1024 + c8);
        }
    };
    auto cz_comp = [&](long t0, const u32x4 (&bw)[4], const u32x4 (&u0)[4], const u32x4 (&r1)[4], const u32x4 (&r2)[4]) {
#pragma unroll
        for (int q = 0; q < 4; ++q) {
            const long t = t0 + q * S;
            if (t < TP) {
                const int s = (int)(t & 4095); const float m1 = s >= 1 ? 1.f : 0.f, m2 = s >= 2 ? 1.f : 0.f;
                float z[8];
#pragma unroll
                for (int i = 0; i < 8; ++i) {
                    const float uu = (i & 1) ? bfhi(u0[q][i >> 1]) : bflo(u0[q][i >> 1]);
                    const float bb = (i & 1) ? bfhi(bw[q][i >> 1]) : bflo(bw[q][i >> 1]);
                    const float a1 = ((i & 1) ? bfhi(r1[q][i >> 1]) : bflo(r1[q][i >> 1])) * m1;
                    const float a2 = ((i & 1) ? bfhi(r2[q][i >> 1]) : bflo(r2[q][i >> 1])) * m2;
                    z[i] = bb * (w0[i] * a2 + w1[i] * a1 + w2[i] * uu);
                }
                u32x4 w; w.x = pk_bf16(z[0], z[1]); w.y = pk_bf16(z[2], z[3]); w.z = pk_bf16(z[4], z[5]); w.w = pk_bf16(z[6], z[7]);
                *(u32x4*)(p.o() + t * 1024 + c8) = w;
            }
        }
    };
    {
        long t0 = (long)blockIdx.x * 4 + (tid >> 7);
        if (t0 < TP) {
            u32x4 bA[4], uA[4], pA[4], qA[4], bB[4], uB[4], pB[4], qB[4];
            cz_load(t0, bA, uA, pA, qA);
            for (;;) {
                const long tn = t0 + 4 * S;
                if (tn < TP) cz_load(tn, bB, uB, pB, qB);
                __builtin_amdgcn_sched_barrier(0);
                cz_comp(t0, bA, uA, pA, qA);
                if (tn >= TP) break;
                const long tn2 = tn + 4 * S;
                if (tn2 < TP) cz_load(tn2, bA, uA, pA, qA);
                __builtin_amdgcn_sched_barrier(0);
                cz_comp(tn, bB, uB, pB, qB);
                if (tn2 >= TP) break;
                t0 = tn2;
            }
        }
    }
    for (long t = (long)TP + (long)blockIdx.x * 4 + (tid >> 7); t < T; t += (long)gridDim.x * 4) {
        u32x4 bw = *(const u32x4*)(p.bg() + t * 1024 + c8);
        u32x4 u0 = *(const u32x4*)(p.ub() + t * 1024 + c8);
        float u1[8], u2[8];
        bool h1, h2; const float *s1 = nullptr, *s2 = nullptr;
        if (t < TP) { const int s = (int)(t & 4095); h1 = s >= 1; h2 = s >= 2; }
        else { const long ts = t - TP; const int jt = (int)(ts & 3); const float* st = p.state_conv + ((long)(j * 128 + (ts >> 2)) * 2) * 1024 + c8;
               h1 = jt >= 1; h2 = jt >= 2; if (jt == 0) { s1 = st + 1024; s2 = st; } else if (jt == 1) { s2 = st + 1024; } }
        if (h1) { u32x4 w = *(const u32x4*)(p.ub() + (t - 1) * 1024 + c8);
#pragma unroll
            for (int i = 0; i < 4; ++i) { u1[2 * i] = bflo(w[i]); u1[2 * i + 1] = bfhi(w[i]); } }
        else if (s1) { f32x4 a = *(const f32x4*)s1, b = *(const f32x4*)(s1 + 4);
#pragma unroll
            for (int i = 0; i < 4; ++i) { u1[i] = a[i]; u1[4 + i] = b[i]; } }
        else {
#pragma unroll
            for (int i = 0; i < 8; ++i) u1[i] = 0.f; }
        if (h2) { u32x4 w = *(const u32x4*)(p.ub() + (t - 2) * 1024 + c8);
#pragma unroll
            for (int i = 0; i < 4; ++i) { u2[2 * i] = bflo(w[i]); u2[2 * i + 1] = bfhi(w[i]); } }
        else if (s2) { f32x4 a = *(const f32x4*)s2, b = *(const f32x4*)(s2 + 4);
#pragma unroll
            for (int i = 0; i < 4; ++i) { u2[i] = a[i]; u2[4 + i] = b[i]; } }
        else {
#pragma unroll
            for (int i = 0; i < 8; ++i) u2[i] = 0.f; }
        float z[8];
#pragma unroll
        for (int i = 0; i < 8; ++i) {
            const float uu = (i & 1) ? bfhi(u0[i >> 1]) : bflo(u0[i >> 1]);
            const float bb = (i & 1) ? bfhi(bw[i >> 1]) : bflo(bw[i >> 1]);
            z[i] = bb * (w0[i] * u2[i] + w1[i] * u1[i] + w2[i] * uu);
        }
        u32x4 w; w.x = pk_bf16(z[0], z[1]); w.y = pk_bf16(z[2], z[3]); w.z = pk_bf16(z[4], z[5]); w.w = pk_bf16(z[6], z[7]);
        *(u32x4*)(p.o() + t * 1024 + c8) = w;
    }
}

__device__ __forceinline__ int f2sort(float f) { int b = __float_as_int(f); return b ^ ((b >> 31) & 0x7fffffff); }
__device__ __forceinline__ float sort2f(int s) { return __int_as_float(s ^ ((s >> 31) & 0x7fffffff)); }
__device__ __forceinline__ int shx16(int v, bool oddrow) { const auto r = __builtin_amdgcn_permlane16_swap((unsigned)v, (unsigned)v, false, false); return oddrow ? (int)r[0] : (int)r[1]; }
__device__ __forceinline__ int shx32(int v, bool hi) { const auto r = __builtin_amdgcn_permlane32_swap((unsigned)v, (unsigned)v, false, false); return hi ? (int)r[0] : (int)r[1]; }
#define CE_DESC(a, b) { int _hi = max(a, b), _lo = min(a, b); a = _hi; b = _lo; }
__device__ __forceinline__ void bitonic_merge16(int (&a)[16]) {
#pragma unroll
    for (int jj = 8; jj >= 1; jj >>= 1)
#pragma unroll
        for (int i = 0; i < 16; ++i) { const int l = i ^ jj; if (l > i) CE_DESC(a[i], a[l]); }
}
__device__ __forceinline__ void bitonic_sort16(int (&a)[16]) {
#pragma unroll
    for (int k = 2; k <= 16; k <<= 1)
#pragma unroll
        for (int jj = k >> 1; jj >= 1; jj >>= 1)
#pragma unroll
            for (int i = 0; i < 16; ++i) {
                const int l = i ^ jj;
                if (l > i) { if ((i & k) == 0 || k == 16) { CE_DESC(a[i], a[l]); } else { CE_DESC(a[l], a[i]); } }
            }
}
constexpr unsigned char cOE16[126] = {0,1,2,3,0,2,1,3,1,2,4,5,6,7,4,6,5,7,5,6,0,4,2,6,2,4,1,5,3,7,3,5,1,2,3,4,5,6,8,9,10,11,8,10,9,11,9,10,12,13,14,15,12,14,13,15,13,14,8,12,10,14,10,12,9,13,11,15,11,13,9,10,11,12,13,14,0,8,4,12,4,8,2,10,6,14,6,10,2,4,6,8,10,12,1,9,5,13,5,9,3,11,7,15,7,11,3,5,7,9,11,13,1,2,3,4,5,6,7,8,9,10,11,12,13,14};
__device__ __forceinline__ void oe_sort16(int (&a)[16]) {
#pragma unroll
    for (int c = 0; c < 63; ++c) CE_DESC(a[cOE16[2 * c]], a[cOE16[2 * c + 1]]);
}
__device__ __attribute__((aligned(16))) const unsigned char kCand[64] = {0,4,8,12,16,20,32,36,51,80,112,160,224,255,255,255,1,5,9,13,17,21,33,48,64,81,113,176,240,255,255,255,2,6,10,14,18,22,34,49,65,96,128,192,255,255,255,255,3,7,11,15,19,23,35,50,66,97,144,208,255,255,255,255};
__device__ const unsigned char kPI[64] = {0,0,0,0,0,0,0,0,0,0,0,0,0,0,0,0,1,1,1,1,1,1,1,1,2,2,2,2,2,3,3,3,3,4,4,4,5,5,6,6,7,7,8,9,10,11,12,13,14,15,0,0,0,0,0,0,0,0,0,0,0,0,0,0};
__device__ const unsigned char kPJ[64] = {0,1,2,3,4,5,6,7,8,9,10,11,12,13,14,15,0,1,2,3,4,5,6,7,0,1,2,3,4,0,1,2,3,0,1,2,0,1,0,1,0,1,0,0,0,0,0,0,0,0,0,0,0,0,0,0,0,0,0,0,0,0,0,0};
constexpr unsigned char cPI[64] = {0,0,0,0,0,0,0,0,0,0,0,0,0,0,0,0,1,1,1,1,1,1,1,1,2,2,2,2,2,3,3,3,3,4,4,4,5,5,6,6,7,7,8,9,10,11,12,13,14,15,0,0,0,0,0,0,0,0,0,0,0,0,0,0};
constexpr unsigned char cPJ[64] = {0,1,2,3,4,5,6,7,8,9,10,11,12,13,14,15,0,1,2,3,4,5,6,7,0,1,2,3,4,0,1,2,3,0,1,2,0,1,0,1,0,1,0,0,0,0,0,0,0,0,0,0,0,0,0,0,0,0,0,0,0,0,0,0};

__device__ __forceinline__ void peer_scores_topk(const int tid, int* const sel_idx, float* const sel_g, float* const sel_su, const float* const SU, const float* const SV, const int head, const long trow0, unsigned char* lds, const int skbase, const int xlbase) {
    const int wid = tid >> 6, lane = tid & 63, fr = lane & 15, fq = lane >> 4;
    int* fl = (int*)(lds + xlbase);
    const int rowmine = 16 * wid + fr;
    const u32x4 cw = *(const u32x4*)(kCand + fq * 16);
    __builtin_amdgcn_sched_barrier(0);
    int mine[2][16];
#pragma unroll
    for (int pp = 0; pp < 2; ++pp) {
        f32x4 sc[8];
#pragma unroll
        for (int n = 0; n < 8; ++n) sc[n] = (f32x4){0.f, 0.f, 0.f, 0.f};
#pragma unroll
        for (int kh = 0; kh < 2; ++kh) {
            const unsigned char* Ab = lds + (pp * 2 + kh) * 16384;
            const unsigned char* Bb = lds + skbase + (pp * 2 + kh) * 16384;
#pragma unroll
            for (int k = 0; k < 2; ++k) {
                const bf16x8 a = *(const bf16x8*)(Ab + lds_byte(rowmine, 32 * k + 8 * fq));
#pragma unroll
                for (int n = 0; n < 8; ++n) sc[n] = mfma16(*(const bf16x8*)(Bb + lds_byte(16 * n + fr, 32 * k + 8 * fq)), a, sc[n]);
            }
        }
        int LB[16];
#pragma unroll
        for (int n = 0; n < 4; ++n)
#pragma unroll
            for (int jj = 0; jj < 4; ++jj) {
                mine[pp][4 * n + jj] = (f2sort(sc[n][jj]) & ~127) | (16 * n + 4 * fq + jj);
                LB[4 * n + jj] = (f2sort(sc[4 + n][jj]) & ~127) | (64 + 16 * n + 4 * fq + jj);
            }
        oe_sort16(mine[pp]); oe_sort16(LB);
#pragma unroll
        for (int i = 0; i < 16; ++i) mine[pp][i] = max(mine[pp][i], LB[15 - i]);
        bitonic_merge16(mine[pp]);
#pragma unroll
        for (int lvl = 0; lvl < 2; ++lvl) {
            int bb[16];
#pragma unroll
            for (int i = 0; i < 16; ++i) bb[i] = lvl == 0 ? shx16(mine[pp][15 - i], fq & 1) : shx32(mine[pp][15 - i], fq >> 1);
#pragma unroll
            for (int i = 0; i < 16; ++i) mine[pp][i] = max(mine[pp][i], bb[i]);
            bitonic_merge16(mine[pp]);
        }
        if (fq == 0) {
#pragma unroll
            for (int i = 0; i < 16; ++i) fl[rowmine * 32 + pp * 16 + i] = mine[pp][i];
        }
    }
    int C[16];
    {
#pragma unroll
        for (int slot = 0; slot < 13; ++slot) {
            const int code = (int)((cw[slot >> 2] >> (8 * (slot & 3))) & 255u);
            const int ka = fl[rowmine * 32 + (code >> 4)], kb = fl[rowmine * 32 + 16 + (code & 15)];
            const float sum = sort2f(ka & ~127) + sort2f(kb & ~127);
            C[slot] = code != 255 ? ((f2sort(sum) & ~255) | code) : (int)0x80000000;
        }
        C[13] = C[14] = C[15] = (int)0x80000000;
        oe_sort16(C);
#pragma unroll
        for (int lvl = 0; lvl < 2; ++lvl) {
            int bb[16];
#pragma unroll
            for (int i = 0; i < 16; ++i) bb[i] = lvl == 0 ? shx16(C[15 - i], fq & 1) : shx32(C[15 - i], fq >> 1);
#pragma unroll
            for (int i = 0; i < 16; ++i) C[i] = max(C[i], bb[i]);
            bitonic_merge16(C);
        }
    }
    int c4[4];
#pragma unroll
    for (int i = 0; i < 4; ++i) c4[i] = fq == 0 ? C[i] : fq == 1 ? C[4 + i] : fq == 2 ? C[8 + i] : C[12 + i];
    const float vmax = sort2f(C[0] & ~255);
    float ev[4]; int eidx[4]; float esum = 0.f;
#pragma unroll
    for (int i = 0; i < 4; ++i) {
        ev[i] = __expf(sort2f(c4[i] & ~255) - vmax); esum += ev[i];
        const int ai = fl[rowmine * 32 + ((c4[i] >> 4) & 15)] & 127, bj = fl[rowmine * 32 + 16 + (c4[i] & 15)] & 127;
        eidx[i] = ai * 128 + bj;
    }
    esum += __shfl_xor(esum, 16); esum += __shfl_xor(esum, 32);
    const float einv = 1.0f / esum;
    {
        const long t = trow0 + rowmine;
        const f32x4 svv = {SV[eidx[0]], SV[eidx[1]], SV[eidx[2]], SV[eidx[3]]}, suv = {SU[eidx[0]], SU[eidx[1]], SU[eidx[2]], SU[eidx[3]]};
        *(u32x4*)(sel_idx + t * 128 + head * 16 + 4 * fq) = (u32x4){(unsigned)eidx[0], (unsigned)eidx[1], (unsigned)eidx[2], (unsigned)eidx[3]};
        *(f32x4*)(sel_g + t * 128 + head * 16 + 4 * fq) = (f32x4){ev[0] * einv * svv[0], ev[1] * einv * svv[1], ev[2] * einv * svv[2], ev[3] * einv * svv[3]};
        *(f32x4*)(sel_su + t * 128 + head * 16 + 4 * fq) = suv;
    }
    lds_barrier();
}

struct PeerTile {
    static constexpr bool AFTER_DRAIN = true, PERM = false;
    const float* ssq; const bf16_t* sk; int* sel_idx; float* sel_g; float* sel_su; const float* SU; const float* SV; int tid_; unsigned char* lds;
    __device__ __forceinline__ void tile(f32x4 (&acc)[2][2][4][2], int pm, int head, int, int, int, int) const {
        int tid = tid_; asm volatile("" : "+v"(tid));
        const int wid = tid >> 6, lane = tid & 63, wr = wid >> 2, wc = wid & 3, fr = lane & 15, fq = lane >> 4;
        {
            const bf16_t* skh = sk + ((long)head * 2) * 128 * 128;
#pragma unroll
            for (int pp = 0; pp < 2; ++pp)
#pragma unroll
                for (int kh = 0; kh < 2; ++kh) stage_half(skh + (long)pp * 128 * 128, 0, 128, kh * 64, lds + 65536 + (pp * 2 + kh) * 16384, tid);
        }
        u32x2 qp[2][4][2][2];
        float rsv[2][4];
        {
            f32x4 part[2][4];
#pragma unroll
            for (int ai = 0; ai < 2; ++ai)
#pragma unroll
                for (int m = 0; m < 4; ++m) part[ai][m] = row_ssq_q(ssq, (long)pm * 256 + ai * 128 + 64 * wr + 16 * m + fr, fq);
#pragma unroll
            for (int ai = 0; ai < 2; ++ai)
#pragma unroll
                for (int m = 0; m < 4; ++m) rsv[ai][m] = row_rstd_q(part[ai][m]);
        }
#pragma unroll
        for (int ai = 0; ai < 2; ++ai)
#pragma unroll
            for (int m = 0; m < 4; ++m) {
                const float rs = rsv[ai][m];
#pragma unroll
                for (int bj = 0; bj < 2; ++bj)
#pragma unroll
                    for (int n = 0; n < 2; ++n) { const f32x4 v = acc[ai][bj][m][n] * rs; qp[ai][m][bj][n].x = pk_bf16(v[0], v[1]); qp[ai][m][bj][n].y = pk_bf16(v[2], v[3]); }
            }
        half(tid, qp[0], pm, head, 0, wr, wc, fr, fq);
        half(tid, qp[1], pm, head, 1, wr, wc, fr, fq);
    }
    __device__ __forceinline__ void half(const int tid, const u32x2 (&q)[4][2][2], int pm, int head, int ai, int wr, int wc, int fr, int fq) const {
#pragma unroll
        for (int m = 0; m < 4; ++m)
#pragma unroll
            for (int bj = 0; bj < 2; ++bj)
#pragma unroll
                for (int n = 0; n < 2; ++n)
                    *(u32x2*)(lds + (2 * bj + (wc >> 1)) * 16384 + lds_byte(64 * wr + 16 * m + fr, 32 * (wc & 1) + 16 * n + 4 * fq)) = q[m][bj][n];
        full_barrier();
        peer_scores_topk(tid, sel_idx, sel_g, sel_su, SU, SV, head, (long)pm * 256 + ai * 128, lds, 65536, 131072);
    }
};

__device__ __forceinline__ void copy_cache_shift(const Params& p, const int wid, const int lane, const int first, const int stride) {
    constexpr int NROWS = 2 * 128 * 124;
    for (int w0 = (first * 8 + wid) * 4; w0 < NROWS; w0 += stride * 32) {
        f32x4 kx[4], vx[4]; long off[4];
#pragma unroll
        for (int q = 0; q < 4; ++q) {
            const int w = w0 + q < NROWS ? w0 + q : NROWS - 1; const int jb = w / 124, c = w - jb * 124 + 4;
            off[q] = ((long)jb * 128 + c) * 256 + 4 * lane;
            kx[q] = __builtin_nontemporal_load((const f32x4*)(p.cache_k + off[q])); vx[q] = __builtin_nontemporal_load((const f32x4*)(p.cache_v + off[q]));
        }
#pragma unroll
        for (int q = 0; q < 4; ++q)
            if (w0 + q < NROWS) { __builtin_nontemporal_store(kx[q], (f32x4*)(p.out + O_KS + off[q] - 1024)); __builtin_nontemporal_store(vx[q], (f32x4*)(p.out + O_VS + off[q] - 1024)); }
    }
}

__device__ __forceinline__ void peerq_phase(const int wv, const Params& p, int layer, unsigned char* lds, const int gx, const int gt) {
    asm volatile("; ==== PHASE peerq");
    const int tid = opaque_tid(wv), wid = tid >> 6, lane = tid & 63, fr = lane & 15, fq = lane >> 4;
    const bf16_t* Bt = p.wq_t() + (long)layer * 2048 * 1024;
    const bool xmap = (gridDim.x & 7) == 0;
    const int G8 = (int)gridDim.x >> 3;
    for (int xr = 0; xr < (XPROBE == 3 ? 2 : 1); ++xr)
    for (int u = xmap ? gx * 64 + gt : (int)blockIdx.x; u < (xmap ? (gx + 1) * 64 : 512); u += (xmap ? G8 : (int)gridDim.x))
        gemm256_units(tid, (LAS unsigned char*)lds, p.hb(), Bt, 8, u, (int)gridDim.x, u + 1, PeerTile{p.ssq(), p.subk() + ((long)layer * 16) * 128 * 128, p.sel_idx(), p.sel_g(), p.sel_su(), p.su() + layer * 16384, p.sv() + layer * 16384, tid, lds});
    const int us0 = xmap ? (G8 - 1 - gt) * 8 + gx : (int)gridDim.x - 1 - (int)blockIdx.x;
    if (layer < 3) {
        const int nl = layer + 1;
        const int lo = (!(nl & 1) && xmap && (48 % G8) != 0) ? CVT_QKV_UNITS : 0;
        const int nidle = (int)gridDim.x - 32;
        if (nidle > 0) { if (us0 >= 32) convert_tables(p, wid, lane, nl, us0 - 32, nidle, lo, 1024); }
        else convert_tables(p, wid, lane, nl, (int)blockIdx.x, (int)gridDim.x, lo, 1024);
    }
    if (layer == 3) {
        const int nidle = (int)gridDim.x - 32;
        if (nidle > 0) { if (us0 >= 32) copy_cache_shift(p, wid, lane, us0 - 32, nidle); }
        else copy_cache_shift(p, wid, lane, (int)blockIdx.x, (int)gridDim.x);
    }
    for (int xr = 0; xr < (XPROBE == 4 ? 2 : 1); ++xr)
    for (int us = us0; us < 32; us += gridDim.x) {
        const int mt = 128 + (us >> 3), head = us & 7;
        f32x4 acc[4][4];
        gemm_kloop<2>(tid, p.hb(), (long)mt * 128, Bt, (long)head * 256, lds, acc);
        {
            const bf16_t* sk = p.subk() + ((long)(layer * 8 + head) * 2) * 128 * 128;
#pragma unroll
            for (int pp = 0; pp < 2; ++pp)
#pragma unroll
                for (int kh = 0; kh < 2; ++kh) stage_half(sk + (long)pp * 128 * 128, 0, 128, kh * 64, lds + 65536 + (pp * 2 + kh) * 16384, tid);
        }
        {
            const int wr = wid >> 2, wc = wid & 3;
            float rsv[4];
            {
                f32x4 part[4];
#pragma unroll
                for (int m = 0; m < 4; ++m) part[m] = row_ssq_q(p.ssq(), (long)mt * 128 + 64 * wr + 16 * m + fr, fq);
#pragma unroll
                for (int m = 0; m < 4; ++m) rsv[m] = row_rstd_q(part[m]);
            }
#pragma unroll
            for (int m = 0; m < 4; ++m) {
                const int r = 64 * wr + 16 * m + fr; const float rs = rsv[m];
#pragma unroll
                for (int n = 0; n < 4; ++n) { f32x4 v = acc[m][n] * rs; u32x2 w; w.x = pk_bf16(v[0], v[1]); w.y = pk_bf16(v[2], v[3]); *(u32x2*)(lds + wc * 16384 + lds_byte(r, 16 * n + 4 * fq)) = w; }
            }
        }
        full_barrier();
        peer_scores_topk(tid, p.sel_idx(), p.sel_g(), p.sel_su(), p.su() + layer * 16384, p.sv() + layer * 16384, head, (long)mt * 128, lds, 65536, 131072);
    }
}

template <int CTRL> __device__ __forceinline__ float dpp_add(float v) { return v + dpp_f<CTRL>(v); }

__device__ __forceinline__ void g1_phase(const int wv, const Params& p, int layer, unsigned char* lds, const int x, const int tgi) {
    asm volatile("; ==== PHASE g1");
    const int tid = opaque_tid(wv), wid = __builtin_amdgcn_readfirstlane(tid >> 6), lane = tid & 63, r = lane & 15, q = lane >> 4, g8 = lane >> 3, jj = lane & 7;
    const int ntg = gridDim.x >> 3;
    if (tgi >= ntg) return;
    unsigned char* const wl = lds + wid * 19200;
    int* const idxb = (int*)(wl + 16384); float* const xfb = (float*)(wl + 17408); float* const sqb = (float*)(wl + 18432); unsigned char* const xq = wl + 18944;
    const unsigned char* const ws = p.ws;
    const unsigned ubase = (unsigned)(WS_U8 + ((size_t)(layer * 8 + x) * 16384) * 128);
    const int pb = 2 * lane, pjj = pb >> 4, pi = (pb >> 2) & 3, pc = pb & 3;
    const f32x2 gf2 = *(const f32x2*)(p.g_ffn + layer * 1024 + 256 * pi + 32 * x + 4 * pjj + pc) * 8.0f;
    const int ts = ntg * 8, t0 = tgi * 8 + wid;
#define G1_DMA4(src, dst) __builtin_amdgcn_global_load_lds((const unsigned*)(src), (unsigned*)(dst), 4, 0, 0)
#define G1_DMA16(src, dst) __builtin_amdgcn_global_load_lds((const unsigned*)(src), (unsigned*)(dst), 16, 0, 0)
#define G1_WAITV(n) asm volatile("s_waitcnt vmcnt(" #n ")" ::: "memory")
    auto meta = [&](int t, int buf) {
        const int tc = t < T ? t : T - 1;
        G1_DMA4(ws + ((unsigned)WS_SELI + (unsigned)(tc * 128 + lane) * 4u), (unsigned char*)(idxb + buf * 128));
        G1_DMA4(ws + ((unsigned)WS_SELI + (unsigned)(tc * 128 + 64 + lane) * 4u), (unsigned char*)(idxb + buf * 128 + 64));
        G1_DMA4(ws + ((unsigned)WS_HB + (unsigned)(tc * 1024 + 256 * (lane >> 4) + 32 * x + 2 * (lane & 15)) * 2u), (unsigned char*)(xfb + buf * 128));
        G1_DMA4(ws + ((unsigned)WS_SSQ + (unsigned)(tc * 16 + (lane & 15)) * 4u), (unsigned char*)(sqb + buf * 64));
    };
    auto prep = [&](int buf, i32x8& xb) {
        const f32x4 s0 = *(const f32x4*)(sqb + buf * 64), s1 = *(const f32x4*)(sqb + buf * 64 + 4), s2 = *(const f32x4*)(sqb + buf * 64 + 8), s3 = *(const f32x4*)(sqb + buf * 64 + 12);
        const float ssum = ((s0[0] + s0[1]) + (s0[2] + s0[3])) + ((s1[0] + s1[1]) + (s1[2] + s1[3])) + ((s2[0] + s2[1]) + (s2[2] + s2[3])) + ((s3[0] + s3[1]) + (s3[2] + s3[3]));
        const float rs = rsqrtf(ssum * (1.0f / 1024.0f) + EPS);
        const unsigned xw = *(const unsigned*)((const unsigned char*)(xfb + buf * 128) + (32 * pi + 4 * pjj + pc) * 2);
        const float v0 = fminf(fmaxf(bflo(xw) * gf2[0] * rs, -440.f), 440.f), v1 = fminf(fmaxf(bfhi(xw) * gf2[1] * rs, -440.f), 440.f);
        const int ph = __builtin_amdgcn_cvt_pk_fp8_f32(v0, v1, 0, false);
        const f32x2 d = __builtin_amdgcn_cvt_pk_f32_fp8(ph, false);
        const int pl = __builtin_amdgcn_cvt_pk_fp8_f32(v0 - d[0], v1 - d[1], 0, false);
        *(unsigned short*)(xq + pb) = (unsigned short)ph; *(unsigned short*)(xq + 128 + pb) = (unsigned short)pl;
        asm volatile("s_waitcnt lgkmcnt(0)" ::: "memory");
        { const unsigned char* xs = xq + 128 * (r & 1) + 32 * q; const u32x4 h0 = *(const u32x4*)xs, h1 = *(const u32x4*)(xs + 16);
          xb = (i32x8){(int)h0.x, (int)h0.y, (int)h0.z, (int)h0.w, (int)h1.x, (int)h1.y, (int)h1.z, (int)h1.w}; }
        asm volatile("s_waitcnt lgkmcnt(0)" ::: "memory");
    };
    auto idx_q = [&](int buf, int qt, unsigned (&raw)[4]) {
        const int* ib = idxb + buf * 128 + 32 * qt;
#pragma unroll
        for (int m = 0; m < 4; ++m) raw[m] = (unsigned)ib[8 * m + g8];
    };
    auto dma_q = [&](int qt, const unsigned (&raw)[4]) {
#pragma unroll
        for (int m = 0; m < 4; ++m) {
            const int row = 8 * m + g8;
            const unsigned off = ubase + raw[m] * 128u + (unsigned)((jj ^ ((row >> 1) & 7)) * 16);
            G1_DMA16(ws + off, wl + qt * 4096 + m * 1024);
        }
    };
    auto lines_q = [&](int buf, int qt) { unsigned off[4]; idx_q(buf, qt, off); dma_q(qt, off); };
    auto frags_q = [&](int qt, i32x8 (&a)[2]) {
        const unsigned char* hb = wl + qt * 4096;
#pragma unroll
        for (int b = 0; b < 2; ++b) {
            const int row = 16 * b + r, f = (row >> 1) & 7;
            const u32x4 lo = *(const u32x4*)(hb + row * 128 + (((2 * q) ^ f) * 16)), hi = *(const u32x4*)(hb + row * 128 + (((2 * q + 1) ^ f) * 16));
            a[b] = (i32x8){(int)lo.x, (int)lo.y, (int)lo.z, (int)lo.w, (int)hi.x, (int)hi.y, (int)hi.z, (int)hi.w};
        }
        asm volatile("s_waitcnt lgkmcnt(0)" ::: "memory");
    };
    auto compute_q = [&](int qt, const i32x8 (&a)[2], const i32x8& xb, f32x4& keep) {
#pragma unroll
        for (int b = 0; b < 2; ++b) {
            f32x4 c = __builtin_amdgcn_mfma_scale_f32_16x16x128_f8f6f4(a[b], xb, (f32x4){0.f, 0.f, 0.f, 0.f}, 0, 0, 0, 0x7f7f7f7f, 0, 0x7f7f7f7f);
            asm("" : "+v"(c) : "v"(a[b]), "v"(xb));
            if (qt == 0 && b == 0) keep = c;
            else {
                const bool mine = (r >> 1) == 2 * qt + b;
#pragma unroll
                for (int e = 0; e < 4; ++e) keep[e] = mine ? c[e] : keep[e];
            }
        }
    };
    auto finish = [&](int t, const f32x4 keep) {
        const unsigned dst = t < T ? (unsigned)WS_PART + (unsigned)((t * 8 + x) * 128 + 16 * (r >> 1) + 4 * q) * 2u : (unsigned)WS_DMY + (unsigned)(lane * 16);
        f32x4 kk;
#pragma unroll
        for (int e = 0; e < 4; ++e) kk[e] = (keep[e] + dpp_f<0xB1>(keep[e])) * 0.125f;
        u32x2 w; w.x = pk_bf16(kk[0], kk[1]); w.y = pk_bf16(kk[2], kk[3]);
        if ((r & 1) == 0) *(u32x2*)(const_cast<unsigned char*>(ws) + dst) = w;
    };
    i32x8 xbA, xbB, fa[2]; f32x4 keep;
    meta(t0, 0); G1_WAITV(0); prep(0, xbA);
    meta(t0 + ts, 1); lines_q(0, 0); lines_q(0, 1); lines_q(0, 2); lines_q(0, 3); keep[0] = keep[1] = keep[2] = keep[3] = gf2[0]; finish(T, keep);
    for (int ta = t0; ta < T; ta += 2 * ts) {
        const int tb = ta + ts;
        meta(ta + 2 * ts, 0);
#pragma unroll
        for (int qt = 0; qt < 4; ++qt) {
            G1_WAITV(16);
            unsigned ofs[4]; idx_q(1, qt, ofs);
            frags_q(qt, fa);
            dma_q(qt, ofs);
            if (qt == 0) prep(1, xbB);
            compute_q(qt, fa, xbA, keep);
        }
        finish(ta, keep);
        meta(tb + 2 * ts, 1);
#pragma unroll
        for (int qt = 0; qt < 4; ++qt) {
            G1_WAITV(16);
            unsigned ofs[4]; idx_q(0, qt, ofs);
            frags_q(qt, fa);
            dma_q(qt, ofs);
            if (qt == 0) prep(0, xbA);
            compute_q(qt, fa, xbB, keep);
        }
        finish(tb, keep);
    }
    G1_WAITV(0);
#undef G1_DMA4
#undef G1_DMA16
#undef G1_WAITV
}

__device__ __forceinline__ void g15_phase(const int wv, const Params& p, int layer, float* wout) {
    asm volatile("; ==== PHASE g15");
    const int tid = opaque_tid(wv), wid = tid >> 6, lane = tid & 63;
    const long ts = (long)gridDim.x * 8;
    const unsigned* part = (const unsigned*)(p.ws + WS_PART);
    for (long tb = (long)blockIdx.x * 8 + wid; tb < T; tb += 3 * ts) {
        unsigned pw[3][8]; f32x2 gk[3], su[3];
#pragma unroll
        for (int q = 0; q < 3; ++q) {
            const long t = tb + q * ts, tc = t < T ? t : T - 1;
#pragma unroll
            for (int x = 0; x < 8; ++x) pw[q][x] = __builtin_nontemporal_load(part + ((long)tc * 8 + x) * 64 + lane);
            gk[q] = *(const f32x2*)(p.sel_g() + tc * 128 + 2 * lane); su[q] = *(const f32x2*)(p.sel_su() + tc * 128 + 2 * lane);
        }
#pragma unroll
        for (int q = 0; q < 3; ++q) {
            const long t = tb + q * ts;
            float s0 = 0.f, s1 = 0.f;
#pragma unroll
            for (int x = 0; x < 8; ++x) { s0 += bflo(pw[q][x]); s1 += bfhi(pw[q][x]); }
            f32x2 o;
            { const float hv = s0 * su[q][0]; o[0] = gk[q][0] * (0.5f * hv * (1.0f + erff(hv * 0.70710678118654752f))); }
            { const float hv = s1 * su[q][1]; o[1] = gk[q][1] * (0.5f * hv * (1.0f + erff(hv * 0.70710678118654752f))); }
            if (t < T) *(f32x2*)(wout + t * 128 + 2 * lane) = o;
        }
    }
}

struct G2Meta { int i0, i1; float w0, w1; unsigned hold; };
__device__ __forceinline__ void g2_phase(const int wv, const Params& p, int layer, unsigned char* lds, const bool dry, const int x, const int tgi) {
    asm volatile("; ==== PHASE g2");
    unsigned char* const ws = p.ws;
    const unsigned hbo = dry ? (unsigned)(WS_DMY + (size_t)T * 4096) : (unsigned)WS_HB, sqo = dry ? (unsigned)(WS_DMY + (size_t)T * 6144) : (unsigned)WS_SSQ;
    const int tid = opaque_tid(wv), wid = __builtin_amdgcn_readfirstlane(tid >> 6), lane = tid & 63, g = lane >> 3, jj = lane & 7;
    const int ntg = gridDim.x >> 3;
    if (tgi >= ntg) return;
    int* wbase = (int*)lds + wid * 512;
    const unsigned voff = (unsigned)(WS_V8 + ((size_t)(layer * 8 + x) * 16384) * 128) + (unsigned)jj * 16u;
    const bool b0 = g & 1, b1 = (g >> 1) & 1, b2 = (g >> 2) & 1;
    const int dd = 256 * (2 * (int)b1 + (int)b2) + 32 * x + 4 * jj + 2 * (int)b0;
    const int ts = ntg * 8, t0 = tgi * 8 + wid;
    auto load_meta = [&](int t, G2Meta& m) {
        const int tc = t < T ? t : T - 1;
        const unsigned so = (unsigned)(tc * 128 + lane) * 4u;
        m.i0 = *(const int*)(ws + ((unsigned)WS_SELI + so)); m.i1 = *(const int*)(ws + ((unsigned)WS_SELI + so + 256u));
        m.w0 = *(const float*)(ws + ((unsigned)WS_SELG + so)); m.w1 = *(const float*)(ws + ((unsigned)WS_SELG + so + 256u));
        m.hold = *(const unsigned*)(ws + ((unsigned)WS_HB + (unsigned)(tc * 1024 + dd) * 2u));
    };
    auto write_lds = [&](const G2Meta& m, int buf) {
        int* w = wbase + buf * 256; float* wf = (float*)(w + 128);
        w[lane] = m.i0; w[64 + lane] = m.i1; wf[lane] = m.w0; wf[64 + lane] = m.w1;
        asm volatile("s_waitcnt lgkmcnt(0)" ::: "memory");
    };
    auto issue = [&](int buf, int hf, u32x4 (&ln)[8]) {
        const int* w = wbase + buf * 256 + 64 * hf;
#pragma unroll
        for (int q = 0; q < 8; ++q) { const unsigned off = (unsigned)w[8 * q + g] * 128u + voff; ln[q] = *(const u32x4*)(ws + off); }
    };
    auto finish = [&](int t, const f32x2 (&y)[8], const unsigned hold) {
        float z[8], zz[4], r[2];
#pragma unroll
        for (int q = 0; q < 8; ++q) { const float ya = y[q >> 1][q & 1], yb = y[4 + (q >> 1)][q & 1];
            const auto sw = __builtin_amdgcn_permlane16_swap(__float_as_uint(ya), __float_as_uint(yb), false, false); const unsigned s0 = sw[0], s1 = sw[1];
            z[q] = __uint_as_float(s0) + __uint_as_float(s1); }
#pragma unroll
        for (int q = 0; q < 4; ++q) { const auto sw = __builtin_amdgcn_permlane32_swap(__float_as_uint(z[q]), __float_as_uint(z[4 + q]), false, false); const unsigned s0 = sw[0], s1 = sw[1];
            zz[q] = __uint_as_float(s0) + __uint_as_float(s1); }
#pragma unroll
        for (int q = 0; q < 2; ++q) { const float kp = b0 ? zz[2 + q] : zz[q], sd = b0 ? zz[q] : zz[2 + q]; r[q] = kp + dpp_f<0x128>(sd); }
        const f32x2 hn = {bflo(hold) + r[0], bfhi(hold) + r[1]};
        const float ss = wave_sum(hn[0] * hn[0] + hn[1] * hn[1]);
        if (t < T) {
            *(unsigned*)(ws + (hbo + (unsigned)(t * 1024 + dd) * 2u)) = pk_bf16(hn[0], hn[1]);
            if (lane == 0) { *(float*)(ws + (sqo + (unsigned)(t * 16 + x) * 4u)) = ss; *(float*)(ws + (sqo + (unsigned)(t * 16 + 8 + x) * 4u)) = 0.f; }
        }
    };
    auto lds_lists = [&](int bufc, int bufn, float (&wks)[16], unsigned (&ids)[16]) {
        const float* wf = (const float*)(wbase + bufc * 256 + 128);
        const int* wn = wbase + bufn * 256;
#pragma unroll
        for (int m = 0; m < 16; ++m) { wks[m] = wf[8 * m + g]; ids[m] = (unsigned)wn[8 * m + g]; }
        asm volatile("s_waitcnt lgkmcnt(0)" : "+v"(wks[0]), "+v"(wks[1]), "+v"(wks[2]), "+v"(wks[3]), "+v"(wks[4]), "+v"(wks[5]), "+v"(wks[6]), "+v"(wks[7]),
                                                "+v"(wks[8]), "+v"(wks[9]), "+v"(wks[10]), "+v"(wks[11]), "+v"(wks[12]), "+v"(wks[13]), "+v"(wks[14]), "+v"(wks[15]) :: "memory");
        asm volatile("" : "+v"(ids[0]), "+v"(ids[1]), "+v"(ids[2]), "+v"(ids[3]), "+v"(ids[4]), "+v"(ids[5]), "+v"(ids[6]), "+v"(ids[7]),
                          "+v"(ids[8]), "+v"(ids[9]), "+v"(ids[10]), "+v"(ids[11]), "+v"(ids[12]), "+v"(ids[13]), "+v"(ids[14]), "+v"(ids[15]) :: "memory");
    };
    auto compute_roll = [&](int hf, const float (&wks)[16], const unsigned (&ids)[16], u32x4 (&ln)[8], f32x2 (&y)[8]) {
#pragma unroll
        for (int m = 0; m < 8; ++m) {
            const float wk = wks[8 * hf + m]; const f32x2 wk2 = {wk, wk};
            u32x4 lw = ln[m];
            asm volatile("" : "+v"(lw) : "v"(y[0]), "v"(y[7]));
            { const unsigned off = ids[8 * hf + m] * 128u + voff; ln[m] = *(const u32x4*)(ws + off); }
#pragma unroll
            for (int i = 0; i < 4; ++i) {
                const f32x2 lo = __builtin_amdgcn_cvt_pk_f32_fp8((int)lw[i], false), hi = __builtin_amdgcn_cvt_pk_f32_fp8((int)lw[i], true);
                y[2 * i] = __builtin_elementwise_fma(wk2, lo, y[2 * i]); y[2 * i + 1] = __builtin_elementwise_fma(wk2, hi, y[2 * i + 1]);
            }
        }
    };
    G2Meta mA, mB; u32x4 H0[8], H1[8]; unsigned hoA, hoB; f32x2 y[8];
    load_meta(t0, mA); write_lds(mA, 0); hoA = mA.hold; issue(0, 0, H0); issue(0, 1, H1);
    load_meta(t0 + ts, mB); write_lds(mB, 1); hoB = mB.hold;
    for (int ta = t0; ta < T; ta += 2 * ts) {
        const int tb = ta + ts;
        load_meta(ta + 2 * ts, mA);
#pragma unroll
        for (int q = 0; q < 8; ++q) y[q] = (f32x2){0.f, 0.f};
        float wks[16]; unsigned ids[16];
        lds_lists(0, 1, wks, ids);
        __builtin_amdgcn_sched_barrier(0);
        compute_roll(0, wks, ids, H0, y);
        __builtin_amdgcn_sched_barrier(0);
        compute_roll(1, wks, ids, H1, y);
        __builtin_amdgcn_sched_barrier(0);
        finish(ta, y, hoA);
        write_lds(mA, 0); hoA = mA.hold;
        load_meta(tb + 2 * ts, mB);
#pragma unroll
        for (int q = 0; q < 8; ++q) y[q] = (f32x2){0.f, 0.f};
        lds_lists(1, 0, wks, ids);
        __builtin_amdgcn_sched_barrier(0);
        compute_roll(0, wks, ids, H0, y);
        __builtin_amdgcn_sched_barrier(0);
        compute_roll(1, wks, ids, H1, y);
        __builtin_amdgcn_sched_barrier(0);
        finish(tb, y, hoB);
        write_lds(mB, 1); hoB = mB.hold;
    }
}

__device__ __forceinline__ void final_phase(const int wv, const Params& p) {
    asm volatile("; ==== PHASE final");
    const int tid = opaque_tid(wv), wid = __builtin_amdgcn_readfirstlane(tid >> 6), lane = tid & 63;
    f32x4 gf[4];
#pragma unroll
    for (int i = 0; i < 4; ++i) gf[i] = *(const f32x4*)(p.g_final + 256 * i + 4 * lane);
    for (long t0 = (long)blockIdx.x * 8 + wid; t0 < T; t0 += (long)gridDim.x * 16) {
        const long t1 = t0 + (long)gridDim.x * 8; const bool two = t1 < T; const long t1c = two ? t1 : t0;
        u32x2 h0[4], h1[4];
#pragma unroll
        for (int i = 0; i < 4; ++i) { h0[i] = *(const u32x2*)(p.hb() + t0 * 1024 + 256 * i + 4 * lane); h1[i] = *(const u32x2*)(p.hb() + t1c * 1024 + 256 * i + 4 * lane); }
        const float rs0 = row_rstd(p.ssq(), t0), rs1 = row_rstd(p.ssq(), t1c);
        float* d0 = t0 < TP ? p.out + O_YP + t0 * 1024 : p.out + O_YS + (t0 - TP) * 1024;
        float* d1 = t1c < TP ? p.out + O_YP + t1c * 1024 : p.out + O_YS + (t1c - TP) * 1024;
#pragma unroll
        for (int i = 0; i < 4; ++i) __builtin_nontemporal_store((f32x4){bflo(h0[i].x), bfhi(h0[i].x), bflo(h0[i].y), bfhi(h0[i].y)} * gf[i] * rs0, (f32x4*)(d0 + 256 * i + 4 * lane));
        if (two) {
#pragma unroll
            for (int i = 0; i < 4; ++i) __builtin_nontemporal_store((f32x4){bflo(h1[i].x), bfhi(h1[i].x), bflo(h1[i].y), bfhi(h1[i].y)} * gf[i] * rs1, (f32x4*)(d1 + 256 * i + 4 * lane));
        }
    }
}

#define XB_TMO      128
#define XB_XCNT(j)  (256  + 64 * (j))
#define XB_XSUB(j)  (1280 + 64 * (j))
#define XB_XGEN(j)  (2304 + 64 * (j))
#define XB_TOP      3328
#define XB_TOPGEN   3392
#define XCD_BAR_WORDS 3456
#define XB_SPIN_CAP (1u << 22)
__device__ __forceinline__ unsigned xb_ld(unsigned* p)              { return __hip_atomic_load(p, __ATOMIC_RELAXED, __HIP_MEMORY_SCOPE_AGENT); }
__device__ __forceinline__ unsigned xb_add(unsigned* p, unsigned v) { return __hip_atomic_fetch_add(p, v, __ATOMIC_RELAXED, __HIP_MEMORY_SCOPE_AGENT); }
__device__ __forceinline__ unsigned xb_xcc_id() { return (unsigned)__builtin_amdgcn_s_getreg((3 << 11) | 20) & 0xFu; }
#define XB_SPIN(cond, bar) do { unsigned _sp = 0; while (cond) { __builtin_amdgcn_s_sleep(6); \
    if ((++_sp & 255u) == 0u) { if (xb_ld(&(bar)[XB_TMO])) break; if (_sp > XB_SPIN_CAP) { atomicAdd(&(bar)[XB_TMO], 1u); break; } } } } while (0)
struct XcdBarrier { unsigned* bar; unsigned x, nloc, nx; };
__device__ __forceinline__ unsigned xcd_barrier_post(XcdBarrier& b, unsigned* bar) {
    b.bar = bar; b.x = xb_xcc_id(); b.nloc = 0u; b.nx = 0u;
    unsigned rank = 0u;
    if (threadIdx.x == 0) rank = xb_add(&bar[XB_XCNT(b.x)], 1u);
    return rank;
}
__device__ __forceinline__ void xcd_barrier_complete(unsigned* bar, unsigned x, unsigned& nloc, unsigned& nx) {
    const unsigned G = gridDim.x;
    unsigned sum, cnt, mine, sp = 0u;
    for (;;) {
        sum = 0u; cnt = 0u; mine = 0u;
#pragma unroll
        for (unsigned j = 0; j < 16; ++j) { const unsigned c = xb_ld(&bar[XB_XCNT(j)]); sum += c; cnt += (c > 0u) ? 1u : 0u; mine = (j == x) ? c : mine; }
        if (sum == G) break;
        __builtin_amdgcn_s_sleep(1);
        if ((++sp & 255u) == 0u) { if (xb_ld(&bar[XB_TMO])) break; if (sp > XB_SPIN_CAP) { atomicAdd(&bar[XB_TMO], 1u); break; } }
    }
    nloc = mine > 0u ? mine : 1u; nx = cnt > 0u ? cnt : 1u;
}
__device__ __forceinline__ void xcd_barrier(XcdBarrier& b, const int wv) {
    const bool t0 = wv == 0 && lane_id() == 0;
    asm volatile("s_waitcnt vmcnt(0)" ::: "memory");
    __syncthreads();
    if (b.nloc == 0u) {
        unsigned nl = 0u, nxx = 0u;
        if (t0) xcd_barrier_complete(b.bar, b.x, nl, nxx);
        b.nloc = __builtin_amdgcn_readfirstlane(nl); b.nx = __builtin_amdgcn_readfirstlane(nxx);
    }
    if (t0) {
        unsigned* bar = b.bar;
        __builtin_amdgcn_s_waitcnt(0);
        const unsigned nloc = b.nloc, nx = b.nx;
        const unsigned old = xb_add(&bar[XB_XSUB(b.x)], 1u);
        const unsigned gen = old / nloc;
        if (old + 1u == (gen + 1u) * nloc) {
            __builtin_amdgcn_fence(__ATOMIC_RELEASE, "agent");
            asm volatile("s_waitcnt vmcnt(0)" ::: "memory");
            const unsigned og = xb_add(&bar[XB_TOP], 1u);
            const unsigned tg = og / nx;
            if (og + 1u == (tg + 1u) * nx) xb_add(&bar[XB_TOPGEN], 1u);
            else XB_SPIN(xb_ld(&bar[XB_TOPGEN]) == tg, bar);
            __builtin_amdgcn_fence(__ATOMIC_ACQUIRE, "agent");
            xb_add(&bar[XB_XGEN(b.x)], 1u);
            asm volatile("s_waitcnt vmcnt(0)" ::: "memory");
        } else {
            XB_SPIN(xb_ld(&bar[XB_XGEN(b.x)]) == gen, bar);
            __builtin_amdgcn_fence(__ATOMIC_ACQUIRE, "agent");
            asm volatile("s_waitcnt vmcnt(0)" ::: "memory");
        }
    }
    __syncthreads();
}

__global__ void __launch_bounds__(NTHREADS) mega(Params p_arg) {
    __shared__ __attribute__((aligned(16))) unsigned char lds[LDS_BYTES];
    cg::grid_group grid = cg::this_grid();
    const int wv = __builtin_amdgcn_readfirstlane((int)threadIdx.x >> 6);
    XcdBarrier xb; const unsigned rank0 = xcd_barrier_post(xb, p_arg.bar());
    if (threadIdx.x == 0) *(volatile unsigned*)lds = rank0;
    __syncthreads();
    const int myrank = __builtin_amdgcn_readfirstlane((int)*(volatile unsigned*)lds);
    __syncthreads();
    int gx = (int)(blockIdx.x & 7), gt = (int)(blockIdx.x >> 3);
    const int phase_lo = p_arg.phase_lo, phase_hi = p_arg.phase_hi;
    if (phase_lo > 1000000) grid.sync();
    for (int ph = phase_lo; ph < phase_hi; ++ph) {
        if (ph == phase_lo + 1) {
            xcd_barrier(xb, wv);
            bool regular = (gridDim.x & 7) == 0;
#pragma unroll
            for (unsigned jx = 0; jx < 16; ++jx) { const unsigned c = xb_ld(&p_arg.bar()[XB_XCNT(jx)]); regular = regular && (c == (jx < 8 ? gridDim.x >> 3 : 0u)); }
            if (regular) { gx = (int)xb.x; gt = myrank; }
        } else if (ph > phase_lo) xcd_barrier(xb, wv);
        const Params& p = p_arg;
        const int layer = (ph - 1) / 7, sub = ph == 0 ? 7 : ph == NPHASES - 1 ? 8 : (ph - 1) % 7, j = layer >> 1;
        const bool isconv = layer & 1;
        const int reps = ((DUPMASK >> sub) & 1) ? 2 : 1;
        for (int rep = 0; rep < reps; ++rep) {
            if (rep) xcd_barrier(xb, wv);
            if (sub == 7) prep_phase(wv, p, lds);
            else if (sub == 8) final_phase(wv, p);
            else if (sub == 0) {
                if (!isconv) gemm_phase(wv, p.hb(), p.wqkv_t() + (long)j * 1536 * 1024, 6, EpiQKV{p, j}, lds, gx, gt);
                else gemm_phase(wv, p.hb(), p.win_t() + (long)j * 3072 * 1024, 12, EpiWin{p, j}, lds, gx, gt);
            } else if (sub == 1) {
                if (!isconv) attn_phase(wv, p, j, lds); else convz_phase(wv, p, j);
            } else if (sub == 2) {
                const bool dry = (DUPMASK & 4) && rep == 0;
                EpiRes er{p.hb(), dry ? (bf16_t*)(p.dmy() + (long)T * 1024) : p.hb(), dry ? p.dmy() + (long)T * 1536 : p.ssq()};
                gemm_phase(wv, p.o(), (isconv ? p.wout_t() : p.wo_t()) + (long)j * 1024 * 1024, 4, er, lds, gx, gt);
            } else if (sub == 3) peerq_phase(wv, p, layer, lds, gx, gt);
            else if (sub == 4) g1_phase(wv, p, layer, lds, gx, gt);
            else if (sub == 5) g15_phase(wv, p, layer, ((DUPMASK & 32) && rep == 0) ? p.dmy() + (long)T * 1552 : p.sel_g());
            else g2_phase(wv, p, layer, lds, (DUPMASK & 64) && rep == 0, gx, gt);
        }
    }
}

extern "C" void kernel_launch(void* const* d_in, const int* in_sizes, int n_in, void* d_out, int out_size, void* d_ws, size_t ws_size, hipStream_t stream) {
    Params p{};
    const float* const* in = (const float* const*)d_in;
    p.x_prompt = in[0]; p.x_sample = in[1]; p.cache_k = in[2]; p.cache_v = in[3]; p.state_conv = in[4]; p.g_mix = in[5]; p.g_ffn = in[6]; p.g_final = in[7]; p.rel_bias = in[8];
    p.w_qkv = in[9]; p.sinks = in[10]; p.w_o = in[11]; p.w_in = in[12]; p.conv_w = in[13]; p.w_out = in[14]; p.w_q = in[15]; p.sub_keys = in[16]; p.peer_u = in[17]; p.peer_v = in[18];
    p.out = (float*)d_out;
    p.ws = (unsigned char*)d_ws;
    if (ws_size < WS_END) fprintf(stderr, "workspace too small: %zu < %zu\n", ws_size, (size_t)WS_END);
    static int grid_blocks = 0;
    if (!grid_blocks) {
        int dev = 0, cus = 0, per_cu = 0;
        hipGetDevice(&dev);
        hipDeviceGetAttribute(&cus, hipDeviceAttributeMultiprocessorCount, dev);
        hipOccupancyMaxActiveBlocksPerMultiprocessor(&per_cu, mega, NTHREADS, 0);
        if (per_cu > 1) per_cu = 1;
        grid_blocks = cus * per_cu;
        if (grid_blocks <= 0) grid_blocks = 256;
    }
    hipMemsetAsync(p.ws + WS_BAR, 0, XCD_BAR_WORDS * 4, stream);
#if ONE_LAUNCH
    p.phase_lo = 0; p.phase_hi = NPHASES;
    void* args[] = {&p};
    hipError_t e = hipLaunchCooperativeKernel((void*)mega, dim3(grid_blocks), dim3(NTHREADS), args, 0, stream);
    if (e != hipSuccess) fprintf(stderr, "cooperative launch failed: %s (grid %d)\n", hipGetErrorString(e), grid_blocks);
#else
    for (int ph = 0; ph < NPHASES; ++ph) {
        p.phase_lo = ph; p.phase_hi = ph + 1;
        hipLaunchKernelGGL(mega, dim3(grid_blocks), dim3(NTHREADS), 0, stream, p);
    }
#endif
}
```
